# Optimizing an MI355X kernel written in HIP

```python
import jax, jax.numpy as jnp
from jax import lax
import numpy as np

D_MODEL = 1024
BATCH = 4
SEQ = 8192
DEPTH = 1

CHUNK = 64
LEFT_CHUNKS = 8
BAND = LEFT_CHUNKS + 1
EPS = 1e-5
D_FF = 2816
SSD_HEADS = 16
SSD_HEAD_DIM = 64
SSD_INNER = SSD_HEADS * SSD_HEAD_DIM
SSD_GROUPS = 2
SSD_STATE = 128
CONV_WIDTH = 4
CONV_DIM = SSD_INNER + 2 * SSD_GROUPS * SSD_STATE
ATT_HEADS = 8
ATT_HEAD_DIM = 64
ATT_INNER = ATT_HEADS * ATT_HEAD_DIM
MAX_REL = 256
MIX_WIDTH = SSD_INNER + ATT_INNER
PROJ_DIM = SSD_INNER + CONV_DIM + SSD_HEADS + 3 * ATT_INNER

kernel_name = "hybrid_ssd_chunkattn_macaron_block"


def rms_norm(x, w):
    xf = x.astype(jnp.float32)
    y = xf * lax.rsqrt(jnp.mean(xf * xf, axis=-1, keepdims=True) + EPS)
    return (y * w.astype(jnp.float32)).astype(x.dtype)


def swiglu(h, w_gate, w_up, w_down):
    return (jax.nn.silu(h @ w_gate) * (h @ w_up)) @ w_down


def causal_depthwise_conv(u, w, b):
    k = w.shape[0]
    out = lax.conv_general_dilated(
        u, w.astype(u.dtype)[:, None, :], window_strides=(1,), padding=[(k - 1, 0)],
        dimension_numbers=('NWC', 'WIO', 'NWC'), feature_group_count=u.shape[-1])
    return out + b.astype(u.dtype)


def ssd_chunked(xs, dt, a, bmat, cmat, d_skip):
    bsz, seqlen, n_heads, hd = xs.shape
    n_groups, n_state = bmat.shape[-2], bmat.shape[-1]
    m = n_heads // n_groups
    nc = seqlen // CHUNK
    xf = xs.astype(jnp.float32)
    xdt = (xf * dt[..., None]).reshape(bsz, nc, CHUNK, n_groups, m, hd)
    a_cs = jnp.cumsum((dt * a).reshape(bsz, nc, CHUNK, n_groups, m), axis=2)
    bc = bmat.astype(jnp.float32).reshape(bsz, nc, CHUNK, n_groups, n_state)
    cc = cmat.astype(jnp.float32).reshape(bsz, nc, CHUNK, n_groups, n_state)
    causal = jnp.tril(jnp.ones((CHUNK, CHUNK), dtype=bool))[:, :, None, None]
    seg = a_cs[:, :, :, None] - a_cs[:, :, None, :]
    decay = jnp.exp(jnp.where(causal, seg, -jnp.inf))
    cb = jnp.einsum('bclgn,bcsgn->bclsg', cc, bc)
    y_diag = jnp.einsum('bclsg,bclsgm,bcsgmp->bclgmp', cb, decay, xdt)
    decay_out = jnp.exp(a_cs[:, :, -1:] - a_cs)
    states = jnp.einsum('bclgn,bclgm,bclgmp->bcgmpn', bc, decay_out, xdt)
    chunk_decay = jnp.exp(a_cs[:, :, -1])

    def step(h, inp):
        s_c, d_c = inp
        return h * d_c[..., None, None] + s_c, h

    h0 = jnp.zeros((bsz, n_groups, m, hd, n_state), jnp.float32)
    _, prev = lax.scan(step, h0, (jnp.moveaxis(states, 1, 0), jnp.moveaxis(chunk_decay, 1, 0)))
    prev = jnp.moveaxis(prev, 0, 1)
    y_off = jnp.einsum('bclgn,bcgmpn,bclgm->bclgmp', cc, prev, jnp.exp(a_cs))
    y = (y_diag + y_off).reshape(bsz, seqlen, n_heads, hd)
    return y + xf * d_skip.astype(jnp.float32)[:, None]


def chunked_rel_attention(q, k, v, rel_bias):
    bsz, seqlen, n_heads, hd = q.shape
    nc = seqlen // CHUNK
    qc = q.reshape(bsz, nc, CHUNK, n_heads, hd)
    pad = ((0, 0), (LEFT_CHUNKS * CHUNK, 0), (0, 0), (0, 0))
    kp = jnp.pad(k, pad).reshape(bsz, nc + LEFT_CHUNKS, CHUNK, n_heads, hd)
    vp = jnp.pad(v, pad).reshape(bsz, nc + LEFT_CHUNKS, CHUNK, n_heads, hd)
    kb = jnp.stack([kp[:, o:o + nc] for o in range(BAND)], axis=2).reshape(bsz, nc, BAND * CHUNK, n_heads, hd)
    vb = jnp.stack([vp[:, o:o + nc] for o in range(BAND)], axis=2).reshape(bsz, nc, BAND * CHUNK, n_heads, hd)
    qpos = LEFT_CHUNKS * CHUNK + jnp.arange(CHUNK)
    kpos = jnp.arange(BAND * CHUNK)
    rel = jnp.clip(qpos[:, None] - kpos[None, :], -MAX_REL, MAX_REL) + MAX_REL
    bias = rel_bias.astype(jnp.float32)[:, rel]
    s = jnp.einsum('bcqhd,bckhd->bhcqk', qc, kb).astype(jnp.float32) * (hd ** -0.5) + bias[None, :, None]
    valid = (jnp.arange(nc)[:, None] - LEFT_CHUNKS + jnp.arange(BAND)[None, :]) >= 0
    valid = jnp.repeat(valid, CHUNK, axis=1)
    s = jnp.where(valid[None, None, :, None, :], s, jnp.finfo(jnp.float32).min)
    p = jax.nn.softmax(s, axis=-1).astype(v.dtype)
    o = jnp.einsum('bhcqk,bckhd->bcqhd', p, vb)
    return o.reshape(bsz, seqlen, n_heads * hd)


def hybrid_mixer(x, mix_norm, w_in, conv_w, conv_b, dt_bias, a_log, d_skip, ssd_norm, rel_bias, w_out):
    bsz, seqlen, _ = x.shape
    h = rms_norm(x, mix_norm)
    proj = h @ w_in
    o1 = SSD_INNER
    o2 = o1 + CONV_DIM
    o3 = o2 + SSD_HEADS
    o4 = o3 + ATT_INNER
    o5 = o4 + ATT_INNER
    z, xbc, dt_raw = proj[..., :o1], proj[..., o1:o2], proj[..., o2:o3]
    q, k, v = proj[..., o3:o4], proj[..., o4:o5], proj[..., o5:]
    xbc = jax.nn.silu(causal_depthwise_conv(xbc, conv_w, conv_b))
    gn = SSD_GROUPS * SSD_STATE
    xs = xbc[..., :SSD_INNER].reshape(bsz, seqlen, SSD_HEADS, SSD_HEAD_DIM)
    bm = xbc[..., SSD_INNER:SSD_INNER + gn].reshape(bsz, seqlen, SSD_GROUPS, SSD_STATE)
    cm = xbc[..., SSD_INNER + gn:].reshape(bsz, seqlen, SSD_GROUPS, SSD_STATE)
    dt = jax.nn.softplus(dt_raw.astype(jnp.float32) + dt_bias.astype(jnp.float32))
    a = -jnp.exp(a_log.astype(jnp.float32))
    y = ssd_chunked(xs, dt, a, bm, cm, d_skip).reshape(bsz, seqlen, SSD_INNER)
    y = rms_norm(y * jax.nn.silu(z.astype(jnp.float32)), ssd_norm).astype(x.dtype)
    att = chunked_rel_attention(
        q.reshape(bsz, seqlen, ATT_HEADS, ATT_HEAD_DIM),
        k.reshape(bsz, seqlen, ATT_HEADS, ATT_HEAD_DIM),
        v.reshape(bsz, seqlen, ATT_HEADS, ATT_HEAD_DIM), rel_bias).astype(x.dtype)
    return jnp.concatenate([y, att], axis=-1) @ w_out


def setup_inputs(seed: int = 0) -> dict:
    key = jax.random.key(seed)
    ks = jax.random.split(key, 24)

    def nrm(k, shape, scale):
        return jax.random.normal(k, shape, jnp.float32) * scale

    def gain(k, n):
        return 1.0 + nrm(k, (DEPTH, n), 0.02)

    u = jax.random.uniform(ks[10], (DEPTH, SSD_HEADS), jnp.float32)
    dt0 = jnp.exp(u * (np.log(0.1) - np.log(0.001)) + np.log(0.001))
    dt_bias = dt0 + jnp.log(-jnp.expm1(-dt0))
    a_log = jnp.log(jax.random.uniform(ks[11], (DEPTH, SSD_HEADS), jnp.float32, 1.0, 16.0))
    return {
        "x": nrm(ks[0], (BATCH, SEQ, D_MODEL), 1.0),
        "ffn1_norm": gain(ks[1], D_MODEL),
        "ffn1_w_gate": nrm(ks[2], (DEPTH, D_MODEL, D_FF), D_MODEL ** -0.5),
        "ffn1_w_up": nrm(ks[3], (DEPTH, D_MODEL, D_FF), D_MODEL ** -0.5),
        "ffn1_w_down": nrm(ks[4], (DEPTH, D_FF, D_MODEL), D_FF ** -0.5),
        "mix_norm": gain(ks[5], D_MODEL),
        "w_in": nrm(ks[6], (DEPTH, D_MODEL, PROJ_DIM), D_MODEL ** -0.5),
        "conv_w": nrm(ks[7], (DEPTH, CONV_WIDTH, CONV_DIM), CONV_WIDTH ** -0.5),
        "conv_b": nrm(ks[8], (DEPTH, CONV_DIM), 0.02),
        "dt_bias": dt_bias,
        "a_log": a_log,
        "d_skip": 1.0 + nrm(ks[12], (DEPTH, SSD_HEADS), 0.1),
        "ssd_norm": gain(ks[13], SSD_INNER),
        "rel_bias": nrm(ks[14], (DEPTH, ATT_HEADS, 2 * MAX_REL + 1), 0.1),
        "w_out": nrm(ks[15], (DEPTH, MIX_WIDTH, D_MODEL), MIX_WIDTH ** -0.5),
        "ffn2_norm": gain(ks[16], D_MODEL),
        "ffn2_w_gate": nrm(ks[17], (DEPTH, D_MODEL, D_FF), D_MODEL ** -0.5),
        "ffn2_w_up": nrm(ks[18], (DEPTH, D_MODEL, D_FF), D_MODEL ** -0.5),
        "ffn2_w_down": nrm(ks[19], (DEPTH, D_FF, D_MODEL), D_FF ** -0.5),
        "final_norm": 1.0 + nrm(ks[20], (D_MODEL,), 0.02),
    }


def reference(x, ffn1_norm, ffn1_w_gate, ffn1_w_up, ffn1_w_down, mix_norm, w_in, conv_w, conv_b,
              dt_bias, a_log, d_skip, ssd_norm, rel_bias, w_out, ffn2_norm, ffn2_w_gate, ffn2_w_up,
              ffn2_w_down, final_norm):
    for i in range(DEPTH):
        x = x + 0.5 * swiglu(rms_norm(x, ffn1_norm[i]), ffn1_w_gate[i], ffn1_w_up[i], ffn1_w_down[i])
        x = x + hybrid_mixer(x, mix_norm[i], w_in[i], conv_w[i], conv_b[i], dt_bias[i], a_log[i],
                             d_skip[i], ssd_norm[i], rel_bias[i], w_out[i])
        x = x + 0.5 * swiglu(rms_norm(x, ffn2_norm[i]), ffn2_w_gate[i], ffn2_w_up[i], ffn2_w_down[i])
    return rms_norm(x, final_norm)
```

```cpp
#include <hip/hip_runtime.h>
#include <cstdio>
#include <cstdint>

namespace {
constexpr int D_MODEL = 1024, BATCH = 4, SEQ = 8192, D_FF = 2816;
constexpr int SSD_HEADS = 16, SSD_INNER = 1024, SSD_STATE = 128, CONV_DIM = 1536;
constexpr int ATT_HEADS = 8, ATT_INNER = 512, MAX_REL = 256, MIX_WIDTH = 1536, PROJ_DIM = 4112;
constexpr int CHUNK = 64, LEFT_CHUNKS = 8;
constexpr float EPS = 1e-5f;

__device__ __forceinline__ float silu_f(float x) { return x / (1.f + expf(-x)); }
__device__ __forceinline__ float softplus_f(float x) { return fmaxf(x, 0.f) + log1pf(expf(-fabsf(x))); }

__global__ void __launch_bounds__(256) rmsnorm_kernel(const float* __restrict__ x, const float* __restrict__ w, float* out, int ld) {
    const int r = blockIdx.x, t = threadIdx.x;
    const float4 v = *(const float4*)(x + (size_t)r * ld + t * 4);
    float s = v.x * v.x + v.y * v.y + v.z * v.z + v.w * v.w;
    for (int o = 32; o > 0; o >>= 1) s += __shfl_xor(s, o);
    __shared__ float red[4];
    if ((t & 63) == 0) red[t >> 6] = s;
    __syncthreads();
    const float tot = red[0] + red[1] + red[2] + red[3];
    const float rs = rsqrtf(tot * (1.f / 1024.f) + EPS);
    const float4 wv = *(const float4*)(w + t * 4);
    float4 o4; o4.x = v.x * rs * wv.x; o4.y = v.y * rs * wv.y; o4.z = v.z * rs * wv.z; o4.w = v.w * rs * wv.w;
    *(float4*)(out + (size_t)r * ld + t * 4) = o4;
}

template <int MODE>
__global__ void __launch_bounds__(256) gemm_f32(const float* __restrict__ A, int lda, const float* __restrict__ B, const float* __restrict__ B2, int ldb,
                                                float* C, int ldc, const float* res, float alpha, int M, int N, int K) {
    __shared__ float As[8][128 + 4];
    __shared__ float Bs[8][128];
    __shared__ float Bs2[MODE == 1 ? 8 : 1][128];
    const int tid = threadIdx.x, tx = tid & 15, ty = tid >> 4;
    const int m0 = blockIdx.y * 128, n0 = blockIdx.x * 128;
    float acc[8][8], acc2[MODE == 1 ? 8 : 1][8];
#pragma unroll
    for (int i = 0; i < 8; ++i)
#pragma unroll
        for (int j = 0; j < 8; ++j) acc[i][j] = 0.f;
    if (MODE == 1) {
#pragma unroll
        for (int i = 0; i < 8; ++i)
#pragma unroll
            for (int j = 0; j < 8; ++j) acc2[i][j] = 0.f;
    }
    const int arow = tid >> 1, akq = (tid & 1) * 4;
    const int bk = tid >> 5, bc = (tid & 31) * 4;
    for (int k0 = 0; k0 < K; k0 += 8) {
        const float4 av = *(const float4*)(A + (size_t)(m0 + arow) * lda + k0 + akq);
        float4 bv = make_float4(0.f, 0.f, 0.f, 0.f), bv2 = bv;
        if (n0 + bc < N) {
            bv = *(const float4*)(B + (size_t)(k0 + bk) * ldb + n0 + bc);
            if (MODE == 1) bv2 = *(const float4*)(B2 + (size_t)(k0 + bk) * ldb + n0 + bc);
        }
        __syncthreads();
        As[akq + 0][arow] = av.x; As[akq + 1][arow] = av.y; As[akq + 2][arow] = av.z; As[akq + 3][arow] = av.w;
        *(float4*)&Bs[bk][bc] = bv;
        if (MODE == 1) *(float4*)&Bs2[bk][bc] = bv2;
        __syncthreads();
#pragma unroll
        for (int k = 0; k < 8; ++k) {
            float a[8], b[8], b2[8];
            const float4 a0 = *(const float4*)&As[k][ty * 4], a1 = *(const float4*)&As[k][64 + ty * 4];
            a[0] = a0.x; a[1] = a0.y; a[2] = a0.z; a[3] = a0.w; a[4] = a1.x; a[5] = a1.y; a[6] = a1.z; a[7] = a1.w;
            const float4 b0 = *(const float4*)&Bs[k][tx * 4], b1 = *(const float4*)&Bs[k][64 + tx * 4];
            b[0] = b0.x; b[1] = b0.y; b[2] = b0.z; b[3] = b0.w; b[4] = b1.x; b[5] = b1.y; b[6] = b1.z; b[7] = b1.w;
            if (MODE == 1) {
                const float4 c0 = *(const float4*)&Bs2[k][tx * 4], c1 = *(const float4*)&Bs2[k][64 + tx * 4];
                b2[0] = c0.x; b2[1] = c0.y; b2[2] = c0.z; b2[3] = c0.w; b2[4] = c1.x; b2[5] = c1.y; b2[6] = c1.z; b2[7] = c1.w;
            }
#pragma unroll
            for (int i = 0; i < 8; ++i)
#pragma unroll
                for (int j = 0; j < 8; ++j) {
                    acc[i][j] = fmaf(a[i], b[j], acc[i][j]);
                    if (MODE == 1) acc2[i][j] = fmaf(a[i], b2[j], acc2[i][j]);
                }
        }
    }
#pragma unroll
    for (int i = 0; i < 8; ++i) {
        const int row = m0 + (i < 4 ? ty * 4 + i : 64 + ty * 4 + (i - 4));
#pragma unroll
        for (int jh = 0; jh < 2; ++jh) {
            const int col = n0 + jh * 64 + tx * 4;
            if (col < N) {
                float4 o;
                float* po = (float*)&o;
#pragma unroll
                for (int j = 0; j < 4; ++j) {
                    const float v = acc[i][jh * 4 + j];
                    if (MODE == 0) po[j] = v;
                    else if (MODE == 1) po[j] = silu_f(v) * acc2[i][jh * 4 + j];
                    else po[j] = v;
                }
                if (MODE == 2) {
                    const float4 rv = *(const float4*)(res + (size_t)row * ldc + col);
                    o.x = rv.x + alpha * o.x; o.y = rv.y + alpha * o.y; o.z = rv.z + alpha * o.z; o.w = rv.w + alpha * o.w;
                }
                *(float4*)(C + (size_t)row * ldc + col) = o;
            }
        }
    }
}

__global__ void __launch_bounds__(256) conv_dt_kernel(const float* __restrict__ proj, const float* __restrict__ cw, const float* __restrict__ cb,
                                                      const float* __restrict__ dt_bias, float* xc, float* dt) {
    const int t = blockIdx.x;
    for (int ch = threadIdx.x; ch < CONV_DIM; ch += 256) {
        float s = cb[ch];
#pragma unroll
        for (int j = 0; j < 4; ++j) {
            const int tt = t - 3 + j;
            if (tt >= 0) s = fmaf(cw[j * CONV_DIM + ch], proj[(size_t)tt * PROJ_DIM + SSD_INNER + ch], s);
        }
        xc[(size_t)t * CONV_DIM + ch] = silu_f(s);
    }
    if (threadIdx.x < 16) dt[t * 16 + threadIdx.x] = softplus_f(proj[(size_t)t * PROJ_DIM + SSD_INNER + CONV_DIM + threadIdx.x] + dt_bias[threadIdx.x]);
}

__global__ void __launch_bounds__(256) ssd_recur_kernel(const float* __restrict__ xc, const float* __restrict__ dt, const float* __restrict__ a_log,
                                                        const float* __restrict__ d_skip, float* y, int L) {
    constexpr int TS = 32;
    __shared__ float Bt[TS][128], Ct[TS][128], xt[TS][64], dtt[TS];
    const int h = blockIdx.x, g = h / 8, tid = threadIdx.x, p = tid >> 2, nq = tid & 3;
    const float a = -expf(a_log[h]), dsk = d_skip[h];
    float hs[32];
#pragma unroll
    for (int i = 0; i < 32; ++i) hs[i] = 0.f;
    for (int t0 = 0; t0 < L; t0 += TS) {
        __syncthreads();
        for (int e = tid; e < TS * 128; e += 256) {
            const int tt = e >> 7, n = e & 127;
            Bt[tt][n] = xc[(size_t)(t0 + tt) * CONV_DIM + SSD_INNER + g * 128 + n];
            Ct[tt][n] = xc[(size_t)(t0 + tt) * CONV_DIM + SSD_INNER + 256 + g * 128 + n];
        }
        for (int e = tid; e < TS * 64; e += 256) { const int tt = e >> 6, pp = e & 63; xt[tt][pp] = xc[(size_t)(t0 + tt) * CONV_DIM + h * 64 + pp]; }
        if (tid < TS) dtt[tid] = dt[(t0 + tid) * 16 + h];
        __syncthreads();
        for (int tt = 0; tt < TS; ++tt) {
            const float dtv = dtt[tt], xv = xt[tt][p], da = expf(dtv * a), xd = dtv * xv;
            float acc = 0.f;
#pragma unroll
            for (int i = 0; i < 32; ++i) {
                hs[i] = fmaf(hs[i], da, xd * Bt[tt][nq * 32 + i]);
                acc = fmaf(Ct[tt][nq * 32 + i], hs[i], acc);
            }
            acc += __shfl_xor(acc, 1); acc += __shfl_xor(acc, 2);
            if (nq == 0) y[(size_t)(t0 + tt) * SSD_INNER + h * 64 + p] = acc + dsk * xv;
        }
    }
}

__global__ void __launch_bounds__(256) gated_norm_kernel(const float* __restrict__ y, const float* __restrict__ proj, const float* __restrict__ w, float* ycat) {
    const int r = blockIdx.x, t = threadIdx.x;
    const float4 yv = *(const float4*)(y + (size_t)r * SSD_INNER + t * 4);
    const float4 zv = *(const float4*)(proj + (size_t)r * PROJ_DIM + t * 4);
    float4 v; v.x = yv.x * silu_f(zv.x); v.y = yv.y * silu_f(zv.y); v.z = yv.z * silu_f(zv.z); v.w = yv.w * silu_f(zv.w);
    float s = v.x * v.x + v.y * v.y + v.z * v.z + v.w * v.w;
    for (int o = 32; o > 0; o >>= 1) s += __shfl_xor(s, o);
    __shared__ float red[4];
    if ((t & 63) == 0) red[t >> 6] = s;
    __syncthreads();
    const float rs = rsqrtf((red[0] + red[1] + red[2] + red[3]) * (1.f / 1024.f) + EPS);
    const float4 wv = *(const float4*)(w + t * 4);
    float4 o4; o4.x = v.x * rs * wv.x; o4.y = v.y * rs * wv.y; o4.z = v.z * rs * wv.z; o4.w = v.w * rs * wv.w;
    *(float4*)(ycat + (size_t)r * MIX_WIDTH + t * 4) = o4;
}

__global__ void __launch_bounds__(64) attn_kernel(const float* __restrict__ proj, const float* __restrict__ rel_bias, float* ycat) {
    __shared__ float Ks[64][64], Vs[64][64], bias_s[2 * MAX_REL + 1];
    const int c = blockIdx.x, h = blockIdx.y, i = threadIdx.x;
    const int QO = SSD_INNER + CONV_DIM + 16, KO = QO + ATT_INNER, VO = KO + ATT_INNER;
    for (int e = i; e < 2 * MAX_REL + 1; e += 64) bias_s[e] = rel_bias[h * (2 * MAX_REL + 1) + e];
    float q[64], o[64];
    const int tq = c * 64 + i;
#pragma unroll
    for (int d = 0; d < 64; ++d) { q[d] = proj[(size_t)tq * PROJ_DIM + QO + h * 64 + d] * 0.125f; o[d] = 0.f; }
    float m = -INFINITY, l = 0.f;
    for (int kc = (c - LEFT_CHUNKS < 0 ? 0 : c - LEFT_CHUNKS); kc <= c; ++kc) {
        __syncthreads();
        for (int e = i; e < 64 * 64; e += 64) {
            const int j = e >> 6, d = e & 63;
            Ks[j][d] = proj[(size_t)(kc * 64 + j) * PROJ_DIM + KO + h * 64 + d];
            Vs[j][d] = proj[(size_t)(kc * 64 + j) * PROJ_DIM + VO + h * 64 + d];
        }
        __syncthreads();
        for (int j = 0; j < 64; ++j) {
            float s = 0.f;
#pragma unroll
            for (int d = 0; d < 64; ++d) s = fmaf(q[d], Ks[j][d], s);
            int rel = tq - (kc * 64 + j); rel = rel < -MAX_REL ? -MAX_REL : (rel > MAX_REL ? MAX_REL : rel);
            s += bias_s[rel + MAX_REL];
            const float mn = fmaxf(m, s), f = expf(m - mn), pj = expf(s - mn);
            l = l * f + pj; m = mn;
#pragma unroll
            for (int d = 0; d < 64; ++d) o[d] = fmaf(o[d], f, pj * Vs[j][d]);
        }
    }
    const float inv = 1.f / l;
#pragma unroll
    for (int d = 0; d < 64; ++d) ycat[(size_t)tq * MIX_WIDTH + SSD_INNER + h * 64 + d] = o[d] * inv;
}
}

extern "C" void kernel_launch(void* const* d_in, const int* in_sizes, int n_in, void* d_out, int out_size, void* d_ws, size_t ws_size, hipStream_t stream) {
    const float* x = (const float*)d_in[0];
    const float *n1 = (const float*)d_in[1], *wg1 = (const float*)d_in[2], *wu1 = (const float*)d_in[3], *wd1 = (const float*)d_in[4];
    const float *nm = (const float*)d_in[5], *w_in = (const float*)d_in[6], *cw = (const float*)d_in[7], *cb = (const float*)d_in[8];
    const float *dt_bias = (const float*)d_in[9], *a_log = (const float*)d_in[10], *d_skip = (const float*)d_in[11], *ssd_norm = (const float*)d_in[12];
    const float *rel_bias = (const float*)d_in[13], *w_out = (const float*)d_in[14];
    const float *n2 = (const float*)d_in[15], *wg2 = (const float*)d_in[16], *wu2 = (const float*)d_in[17], *wd2 = (const float*)d_in[18], *nf = (const float*)d_in[19];
    float* out = (float*)d_out;
    const int L = SEQ;
    char* ws = (char*)d_ws;
    size_t off = 0;
    auto carve = [&](size_t bytes) { float* p = (float*)(ws + off); off += (bytes + 255) & ~(size_t)255; return p; };
    float* HN = carve((size_t)L * D_MODEL * 4);
    float* BIG = carve((size_t)L * PROJ_DIM * 4);
    float* XC = carve((size_t)L * CONV_DIM * 4);
    float* DT = carve((size_t)L * 16 * 4);
    float* Y = carve((size_t)L * SSD_INNER * 4);
    float* YCAT = carve((size_t)L * MIX_WIDTH * 4);
    if (off > ws_size) { fprintf(stderr, "ws too small: need %zu have %zu\n", off, ws_size); return; }
    for (int b = 0; b < BATCH; ++b) {
        const float* xb = x + (size_t)b * L * D_MODEL;
        float* ob = out + (size_t)b * L * D_MODEL;
        rmsnorm_kernel<<<L, 256, 0, stream>>>(xb, n1, HN, D_MODEL);
        gemm_f32<1><<<dim3(D_FF / 128, L / 128), 256, 0, stream>>>(HN, D_MODEL, wg1, wu1, D_FF, BIG, D_FF, nullptr, 0.f, L, D_FF, D_MODEL);
        gemm_f32<2><<<dim3(D_MODEL / 128, L / 128), 256, 0, stream>>>(BIG, D_FF, wd1, nullptr, D_MODEL, ob, D_MODEL, xb, 0.5f, L, D_MODEL, D_FF);
        rmsnorm_kernel<<<L, 256, 0, stream>>>(ob, nm, HN, D_MODEL);
        gemm_f32<0><<<dim3((PROJ_DIM + 127) / 128, L / 128), 256, 0, stream>>>(HN, D_MODEL, w_in, nullptr, PROJ_DIM, BIG, PROJ_DIM, nullptr, 0.f, L, PROJ_DIM, D_MODEL);
        conv_dt_kernel<<<L, 256, 0, stream>>>(BIG, cw, cb, dt_bias, XC, DT);
        ssd_recur_kernel<<<SSD_HEADS, 256, 0, stream>>>(XC, DT, a_log, d_skip, Y, L);
        gated_norm_kernel<<<L, 256, 0, stream>>>(Y, BIG, ssd_norm, YCAT);
        attn_kernel<<<dim3(L / CHUNK, ATT_HEADS), 64, 0, stream>>>(BIG, rel_bias, YCAT);
        gemm_f32<2><<<dim3(D_MODEL / 128, L / 128), 256, 0, stream>>>(YCAT, MIX_WIDTH, w_out, nullptr, D_MODEL, ob, D_MODEL, ob, 1.0f, L, D_MODEL, MIX_WIDTH);
        rmsnorm_kernel<<<L, 256, 0, stream>>>(ob, n2, HN, D_MODEL);
        gemm_f32<1><<<dim3(D_FF / 128, L / 128), 256, 0, stream>>>(HN, D_MODEL, wg2, wu2, D_FF, BIG, D_FF, nullptr, 0.f, L, D_FF, D_MODEL);
        gemm_f32<2><<<dim3(D_MODEL / 128, L / 128), 256, 0, stream>>>(BIG, D_FF, wd2, nullptr, D_MODEL, ob, D_MODEL, ob, 0.5f, L, D_MODEL, D_FF);
        rmsnorm_kernel<<<L, 256, 0, stream>>>(ob, nf, ob, D_MODEL);
    }
}
```

```cpp
#include <hip/hip_runtime.h>
#include <cstdio>
#include <cstdint>
namespace nv {
constexpr int D_MODEL = 1024, BATCH = 4, SEQ = 8192, D_FF = 2816;
constexpr int SSD_HEADS = 16, SSD_INNER = 1024, SSD_STATE = 128, CONV_DIM = 1536;
constexpr int ATT_HEADS = 8, ATT_INNER = 512, MAX_REL = 256, MIX_WIDTH = 1536, PROJ_DIM = 4112;
constexpr int CHUNK = 64, LEFT_CHUNKS = 8;
constexpr float EPS = 1e-5f;

__device__ __forceinline__ float silu_f(float x) { return x / (1.f + expf(-x)); }
__device__ __forceinline__ float softplus_f(float x) { return fmaxf(x, 0.f) + log1pf(expf(-fabsf(x))); }

__global__ void __launch_bounds__(256) rmsnorm_kernel(const float* __restrict__ x, const float* __restrict__ w, float* out, int ld) {
    const int r = blockIdx.x, t = threadIdx.x;
    const float4 v = *(const float4*)(x + (size_t)r * ld + t * 4);
    float s = v.x * v.x + v.y * v.y + v.z * v.z + v.w * v.w;
    for (int o = 32; o > 0; o >>= 1) s += __shfl_xor(s, o);
    __shared__ float red[4];
    if ((t & 63) == 0) red[t >> 6] = s;
    __syncthreads();
    const float tot = red[0] + red[1] + red[2] + red[3];
    const float rs = rsqrtf(tot * (1.f / 1024.f) + EPS);
    const float4 wv = *(const float4*)(w + t * 4);
    float4 o4; o4.x = v.x * rs * wv.x; o4.y = v.y * rs * wv.y; o4.z = v.z * rs * wv.z; o4.w = v.w * rs * wv.w;
    *(float4*)(out + (size_t)r * ld + t * 4) = o4;
}

template <int MODE>
__global__ void __launch_bounds__(256) gemm_f32(const float* __restrict__ A, int lda, const float* __restrict__ B, const float* __restrict__ B2, int ldb,
                                                float* C, int ldc, const float* res, float alpha, int M, int N, int K) {
    __shared__ float As[8][128 + 4];
    __shared__ float Bs[8][128];
    __shared__ float Bs2[MODE == 1 ? 8 : 1][128];
    const int tid = threadIdx.x, tx = tid & 15, ty = tid >> 4;
    const int m0 = blockIdx.y * 128, n0 = blockIdx.x * 128;
    float acc[8][8], acc2[MODE == 1 ? 8 : 1][8];
#pragma unroll
    for (int i = 0; i < 8; ++i)
#pragma unroll
        for (int j = 0; j < 8; ++j) acc[i][j] = 0.f;
    if (MODE == 1) {
#pragma unroll
        for (int i = 0; i < 8; ++i)
#pragma unroll
            for (int j = 0; j < 8; ++j) acc2[i][j] = 0.f;
    }
    const int arow = tid >> 1, akq = (tid & 1) * 4;
    const int bk = tid >> 5, bc = (tid & 31) * 4;
    for (int k0 = 0; k0 < K; k0 += 8) {
        const float4 av = *(const float4*)(A + (size_t)(m0 + arow) * lda + k0 + akq);
        float4 bv = make_float4(0.f, 0.f, 0.f, 0.f), bv2 = bv;
        if (n0 + bc < N) {
            bv = *(const float4*)(B + (size_t)(k0 + bk) * ldb + n0 + bc);
            if (MODE == 1) bv2 = *(const float4*)(B2 + (size_t)(k0 + bk) * ldb + n0 + bc);
        }
        __syncthreads();
        As[akq + 0][arow] = av.x; As[akq + 1][arow] = av.y; As[akq + 2][arow] = av.z; As[akq + 3][arow] = av.w;
        *(float4*)&Bs[bk][bc] = bv;
        if (MODE == 1) *(float4*)&Bs2[bk][bc] = bv2;
        __syncthreads();
#pragma unroll
        for (int k = 0; k < 8; ++k) {
            float a[8], b[8], b2[8];
            const float4 a0 = *(const float4*)&As[k][ty * 4], a1 = *(const float4*)&As[k][64 + ty * 4];
            a[0] = a0.x; a[1] = a0.y; a[2] = a0.z; a[3] = a0.w; a[4] = a1.x; a[5] = a1.y; a[6] = a1.z; a[7] = a1.w;
            const float4 b0 = *(const float4*)&Bs[k][tx * 4], b1 = *(const float4*)&Bs[k][64 + tx * 4];
            b[0] = b0.x; b[1] = b0.y; b[2] = b0.z; b[3] = b0.w; b[4] = b1.x; b[5] = b1.y; b[6] = b1.z; b[7] = b1.w;
            if (MODE == 1) {
                const float4 c0 = *(const float4*)&Bs2[k][tx * 4], c1 = *(const float4*)&Bs2[k][64 + tx * 4];
                b2[0] = c0.x; b2[1] = c0.y; b2[2] = c0.z; b2[3] = c0.w; b2[4] = c1.x; b2[5] = c1.y; b2[6] = c1.z; b2[7] = c1.w;
            }
#pragma unroll
            for (int i = 0; i < 8; ++i)
#pragma unroll
                for (int j = 0; j < 8; ++j) {
                    acc[i][j] = fmaf(a[i], b[j], acc[i][j]);
                    if (MODE == 1) acc2[i][j] = fmaf(a[i], b2[j], acc2[i][j]);
                }
        }
    }
#pragma unroll
    for (int i = 0; i < 8; ++i) {
        const int row = m0 + (i < 4 ? ty * 4 + i : 64 + ty * 4 + (i - 4));
#pragma unroll
        for (int jh = 0; jh < 2; ++jh) {
            const int col = n0 + jh * 64 + tx * 4;
            if (col < N) {
                float4 o;
                float* po = (float*)&o;
#pragma unroll
                for (int j = 0; j < 4; ++j) {
                    const float v = acc[i][jh * 4 + j];
                    if (MODE == 0) po[j] = v;
                    else if (MODE == 1) po[j] = silu_f(v) * acc2[i][jh * 4 + j];
                    else po[j] = v;
                }
                if (MODE == 2) {
                    const float4 rv = *(const float4*)(res + (size_t)row * ldc + col);
                    o.x = rv.x + alpha * o.x; o.y = rv.y + alpha * o.y; o.z = rv.z + alpha * o.z; o.w = rv.w + alpha * o.w;
                }
                *(float4*)(C + (size_t)row * ldc + col) = o;
            }
        }
    }
}

__global__ void __launch_bounds__(256) conv_dt_kernel(const float* __restrict__ proj, const float* __restrict__ cw, const float* __restrict__ cb,
                                                      const float* __restrict__ dt_bias, float* xc, float* dt) {
    const int t = blockIdx.x;
    for (int ch = threadIdx.x; ch < CONV_DIM; ch += 256) {
        float s = cb[ch];
#pragma unroll
        for (int j = 0; j < 4; ++j) {
            const int tt = t - 3 + j;
            if (tt >= 0) s = fmaf(cw[j * CONV_DIM + ch], proj[(size_t)tt * PROJ_DIM + SSD_INNER + ch], s);
        }
        xc[(size_t)t * CONV_DIM + ch] = silu_f(s);
    }
    if (threadIdx.x < 16) dt[t * 16 + threadIdx.x] = softplus_f(proj[(size_t)t * PROJ_DIM + SSD_INNER + CONV_DIM + threadIdx.x] + dt_bias[threadIdx.x]);
}

__global__ void __launch_bounds__(256) ssd_recur_kernel(const float* __restrict__ xc, const float* __restrict__ dt, const float* __restrict__ a_log,
                                                        const float* __restrict__ d_skip, float* y, int L) {
    constexpr int TS = 32;
    __shared__ float Bt[TS][128], Ct[TS][128], xt[TS][64], dtt[TS];
    const int h = blockIdx.x, g = h / 8, tid = threadIdx.x, p = tid >> 2, nq = tid & 3;
    const float a = -expf(a_log[h]), dsk = d_skip[h];
    float hs[32];
#pragma unroll
    for (int i = 0; i < 32; ++i) hs[i] = 0.f;
    for (int t0 = 0; t0 < L; t0 += TS) {
        __syncthreads();
        for (int e = tid; e < TS * 128; e += 256) {
            const int tt = e >> 7, n = e & 127;
            Bt[tt][n] = xc[(size_t)(t0 + tt) * CONV_DIM + SSD_INNER + g * 128 + n];
            Ct[tt][n] = xc[(size_t)(t0 + tt) * CONV_DIM + SSD_INNER + 256 + g * 128 + n];
        }
        for (int e = tid; e < TS * 64; e += 256) { const int tt = e >> 6, pp = e & 63; xt[tt][pp] = xc[(size_t)(t0 + tt) * CONV_DIM + h * 64 + pp]; }
        if (tid < TS) dtt[tid] = dt[(t0 + tid) * 16 + h];
        __syncthreads();
        for (int tt = 0; tt < TS; ++tt) {
            const float dtv = dtt[tt], xv = xt[tt][p], da = expf(dtv * a), xd = dtv * xv;
            float acc = 0.f;
#pragma unroll
            for (int i = 0; i < 32; ++i) {
                hs[i] = fmaf(hs[i], da, xd * Bt[tt][nq * 32 + i]);
                acc = fmaf(Ct[tt][nq * 32 + i], hs[i], acc);
            }
            acc += __shfl_xor(acc, 1); acc += __shfl_xor(acc, 2);
            if (nq == 0) y[(size_t)(t0 + tt) * SSD_INNER + h * 64 + p] = acc + dsk * xv;
        }
    }
}

__global__ void __launch_bounds__(256) gated_norm_kernel(const float* __restrict__ y, const float* __restrict__ proj, const float* __restrict__ w, float* ycat) {
    const int r = blockIdx.x, t = threadIdx.x;
    const float4 yv = *(const float4*)(y + (size_t)r * SSD_INNER + t * 4);
    const float4 zv = *(const float4*)(proj + (size_t)r * PROJ_DIM + t * 4);
    float4 v; v.x = yv.x * silu_f(zv.x); v.y = yv.y * silu_f(zv.y); v.z = yv.z * silu_f(zv.z); v.w = yv.w * silu_f(zv.w);
    float s = v.x * v.x + v.y * v.y + v.z * v.z + v.w * v.w;
    for (int o = 32; o > 0; o >>= 1) s += __shfl_xor(s, o);
    __shared__ float red[4];
    if ((t & 63) == 0) red[t >> 6] = s;
    __syncthreads();
    const float rs = rsqrtf((red[0] + red[1] + red[2] + red[3]) * (1.f / 1024.f) + EPS);
    const float4 wv = *(const float4*)(w + t * 4);
    float4 o4; o4.x = v.x * rs * wv.x; o4.y = v.y * rs * wv.y; o4.z = v.z * rs * wv.z; o4.w = v.w * rs * wv.w;
    *(float4*)(ycat + (size_t)r * MIX_WIDTH + t * 4) = o4;
}

__global__ void __launch_bounds__(64) attn_kernel(const float* __restrict__ proj, const float* __restrict__ rel_bias, float* ycat) {
    __shared__ float Ks[64][64], Vs[64][64], bias_s[2 * MAX_REL + 1];
    const int c = blockIdx.x, h = blockIdx.y, i = threadIdx.x;
    const int QO = SSD_INNER + CONV_DIM + 16, KO = QO + ATT_INNER, VO = KO + ATT_INNER;
    for (int e = i; e < 2 * MAX_REL + 1; e += 64) bias_s[e] = rel_bias[h * (2 * MAX_REL + 1) + e];
    float q[64], o[64];
    const int tq = c * 64 + i;
#pragma unroll
    for (int d = 0; d < 64; ++d) { q[d] = proj[(size_t)tq * PROJ_DIM + QO + h * 64 + d] * 0.125f; o[d] = 0.f; }
    float m = -INFINITY, l = 0.f;
    for (int kc = (c - LEFT_CHUNKS < 0 ? 0 : c - LEFT_CHUNKS); kc <= c; ++kc) {
        __syncthreads();
        for (int e = i; e < 64 * 64; e += 64) {
            const int j = e >> 6, d = e & 63;
            Ks[j][d] = proj[(size_t)(kc * 64 + j) * PROJ_DIM + KO + h * 64 + d];
            Vs[j][d] = proj[(size_t)(kc * 64 + j) * PROJ_DIM + VO + h * 64 + d];
        }
        __syncthreads();
        for (int j = 0; j < 64; ++j) {
            float s = 0.f;
#pragma unroll
            for (int d = 0; d < 64; ++d) s = fmaf(q[d], Ks[j][d], s);
            int rel = tq - (kc * 64 + j); rel = rel < -MAX_REL ? -MAX_REL : (rel > MAX_REL ? MAX_REL : rel);
            s += bias_s[rel + MAX_REL];
            const float mn = fmaxf(m, s), f = expf(m - mn), pj = expf(s - mn);
            l = l * f + pj; m = mn;
#pragma unroll
            for (int d = 0; d < 64; ++d) o[d] = fmaf(o[d], f, pj * Vs[j][d]);
        }
    }
    const float inv = 1.f / l;
#pragma unroll
    for (int d = 0; d < 64; ++d) ycat[(size_t)tq * MIX_WIDTH + SSD_INNER + h * 64 + d] = o[d] * inv;
}
}
namespace nv2 {
__device__ __forceinline__ float bf2f(unsigned short v) { return __uint_as_float((unsigned)v << 16); }
__device__ __forceinline__ unsigned short f2bf_rne(float f) { unsigned u = __float_as_uint(f); return (unsigned short)((u + 0x7fffu + ((u >> 16) & 1u)) >> 16); }
__global__ void __launch_bounds__(256) conv_dt_kernel(const unsigned short* __restrict__ proj, const float* __restrict__ dtraw, const float* __restrict__ cw, const float* __restrict__ cb,
                                                      const float* __restrict__ dt_bias, float* xc, float* dt) {
    const int t = blockIdx.x;
    for (int ch = threadIdx.x; ch < 1536; ch += 256) {
        float s = cb[ch];
#pragma unroll
        for (int j = 0; j < 4; ++j) { const int tt = t - 3 + j; if (tt >= 0) s = fmaf(cw[j * 1536 + ch], bf2f(proj[(size_t)tt * 4096 + 1024 + ch]), s); }
        xc[(size_t)t * 1536 + ch] = nv::silu_f(s);
    }
    if (threadIdx.x < 16) dt[t * 16 + threadIdx.x] = nv::softplus_f(dtraw[t * 16 + threadIdx.x] + dt_bias[threadIdx.x]);
}
__global__ void __launch_bounds__(256) gated_norm_kernel(const float* __restrict__ y, const unsigned short* __restrict__ proj, unsigned short* ycat) {
    const int r = blockIdx.x, t = threadIdx.x;
    const float4 yv = *(const float4*)(y + (size_t)r * 1024 + t * 4);
    const unsigned short* zp = proj + (size_t)r * 4096 + t * 4;
    float4 v; v.x = yv.x * nv::silu_f(bf2f(zp[0])); v.y = yv.y * nv::silu_f(bf2f(zp[1])); v.z = yv.z * nv::silu_f(bf2f(zp[2])); v.w = yv.w * nv::silu_f(bf2f(zp[3]));
    float s = v.x * v.x + v.y * v.y + v.z * v.z + v.w * v.w;
    for (int o = 32; o > 0; o >>= 1) s += __shfl_xor(s, o);
    __shared__ float red[4];
    if ((t & 63) == 0) red[t >> 6] = s;
    __syncthreads();
    const float rs = rsqrtf((red[0] + red[1] + red[2] + red[3]) * (1.f / 1024.f) + 1e-5f);
    unsigned short* o = ycat + (size_t)r * 1536 + t * 4;
    o[0] = f2bf_rne(v.x * rs); o[1] = f2bf_rne(v.y * rs); o[2] = f2bf_rne(v.z * rs); o[3] = f2bf_rne(v.w * rs);
}
__global__ void __launch_bounds__(64) attn_kernel(const unsigned short* __restrict__ proj, const float* __restrict__ rel_bias, unsigned short* ycat) {
    __shared__ float Ks[64][64], Vs[64][64], bias_s[513];
    const int c = blockIdx.x, h = blockIdx.y, i = threadIdx.x;
    for (int e = i; e < 513; e += 64) bias_s[e] = rel_bias[h * 513 + e] * 1.4426950408889634f;
    float q[64], o[64];
    const int tq = c * 64 + i;
#pragma unroll
    for (int d = 0; d < 64; ++d) { q[d] = bf2f(proj[(size_t)tq * 4096 + 2560 + h * 64 + d]); o[d] = 0.f; }
    float m = -INFINITY, l = 0.f;
    for (int kc = (c - 8 < 0 ? 0 : c - 8); kc <= c; ++kc) {
        __syncthreads();
        for (int e = i; e < 64 * 64; e += 64) { const int j = e >> 6, d = e & 63;
            Ks[j][d] = bf2f(proj[(size_t)(kc * 64 + j) * 4096 + 3072 + h * 64 + d]);
            Vs[j][d] = bf2f(proj[(size_t)(kc * 64 + j) * 4096 + 3584 + h * 64 + d]); }
        __syncthreads();
        for (int j = 0; j < 64; ++j) {
            float s = 0.f;
#pragma unroll
            for (int d = 0; d < 64; ++d) s = fmaf(q[d], Ks[j][d], s);
            int rel = tq - (kc * 64 + j); rel = rel < -256 ? -256 : (rel > 256 ? 256 : rel);
            s += bias_s[rel + 256];
            const float mn = fmaxf(m, s), f = exp2f(m - mn), pj = exp2f(s - mn);
            l = l * f + pj; m = mn;
#pragma unroll
            for (int d = 0; d < 64; ++d) o[d] = fmaf(o[d], f, pj * Vs[j][d]);
        }
    }
    const float inv = 1.f / l;
#pragma unroll
    for (int d = 0; d < 64; ++d) ycat[(size_t)tq * 1536 + 1024 + h * 64 + d] = f2bf_rne(o[d] * inv);
}
}
namespace pg8 {
#define PG8_LAS __attribute__((address_space(3)))
typedef unsigned short bf16_t;
typedef short bf16x8 __attribute__((ext_vector_type(8)));
typedef float f32x4 __attribute__((ext_vector_type(4)));
typedef unsigned u32x4 __attribute__((ext_vector_type(4)));
constexpr int BM = 256, BK = 64, HALF = 128, HTB = HALF * BK * 2  , STAGE_BYTES = 8 * HTB, NXCD = 8, WGM = 8;

__host__ __device__ __forceinline__ int lds_byte(int r, int c) { const int st = (r >> 4) * 2 + (c >> 5), rr = r & 15, cc = c & 31, ob = rr * 64 + cc * 2; return st * 1024 + (ob ^ (((ob >> 9) & 1) << 5)); }
__host__ __device__ __forceinline__ void stage_rc(int b, int& R, int& C) { const int st = b / 1024, sb = b % 1024, swz = sb ^ (((sb >> 9) & 1) << 5); R = (st >> 1) * 16 + swz / 64; C = (st & 1) * 32 + (swz % 64) / 2; }
__host__ __device__ __forceinline__ int perm32(int rho) { const int n = rho >> 4, i = rho & 15; return 8 * (i >> 2) + 4 * n + (i & 3); }

struct Unit { int pm, pn; };
struct Gemm { const bf16_t* A; const bf16_t* Bt; int M, N, K; };

struct StaticOrder {
    int nM, nN, nwg, G, c;
    __host__ __device__ void init(int M, int N, int G_, int c_) { nM = M / BM; nN = N / BM; nwg = nM * nN; G = G_; c = c_; }
    __host__ __device__ bool next(int i, Unit& u) const {
        const long L = (long)i * G + c; if (L >= nwg) return false;
        int wgid = (int)L; { const int q = nwg / NXCD, r = nwg % NXCD, xcd = wgid % NXCD, off = wgid / NXCD; wgid = (xcd < r ? xcd * (q + 1) : r * (q + 1) + (xcd - r) * q) + off; }
        const int nig = WGM * nN, gid = wgid / nig, fm = gid * WGM, gsz = (nM - fm) < WGM ? (nM - fm) : WGM;
        u.pm = fm + ((wgid % nig) % gsz); u.pn = (wgid % nig) / gsz; return true;
    }
    __device__ __forceinline__ void a_ready(const Unit&) const {}
    __device__ __forceinline__ void done(const Unit&) const {}
};

__device__ __forceinline__ unsigned cvt_pk_bf16(float lo, float hi) { unsigned r; asm volatile("v_cvt_pk_bf16_f32 %0, %1, %2" : "=v"(r) : "v"(lo), "v"(hi)); return r; }
typedef float f32x2 __attribute__((ext_vector_type(2)));
constexpr float RMS_EPS = 1e-5f;
__device__ __forceinline__ float silu_fast(float g) { return g * __builtin_amdgcn_rcpf(1.0f + __builtin_amdgcn_exp2f(g * -1.4426950408889634f)); }
__device__ __forceinline__ float row_rs(const float* ssq, int row) { return __builtin_amdgcn_rsqf(ssq[row] * (1.0f / 1024.0f) + RMS_EPS); }

struct EpiSwiglu {
    static constexpr bool PERM = true, AFTER_DRAIN = false;
    bf16_t* O; int ldc; const float* ssq;
    __device__ __forceinline__ void operator()(const f32x4 (&acc)[2][2][4][2], const Unit& u, int wr, int wc, int fr, int fq) const {
        const int row0 = u.pm * BM + wr * 64 + fr, col0 = u.pn * HALF + wc * 32 + 8 * fq;
#pragma unroll
        for (int ai = 0; ai < 2; ++ai)
#pragma unroll
            for (int m = 0; m < 4; ++m) {
                const int row = row0 + ai * HALF + m * 16;
                const float rs = row_rs(ssq, row);
                float v[8];
#pragma unroll
                for (int n = 0; n < 2; ++n)
#pragma unroll
                    for (int i = 0; i < 4; ++i) v[n * 4 + i] = silu_fast(acc[ai][0][m][n][i] * rs) * (acc[ai][1][m][n][i] * rs);
                u32x4 w; w.x = cvt_pk_bf16(v[0], v[1]); w.y = cvt_pk_bf16(v[2], v[3]); w.z = cvt_pk_bf16(v[4], v[5]); w.w = cvt_pk_bf16(v[6], v[7]);
                *(u32x4*)(O + (size_t)row * ldc + col0) = w;
            }
    }
};

struct EpiScaleBf16 {
    static constexpr bool PERM = true, AFTER_DRAIN = false;
    bf16_t* O; int ldc; const float* ssq;
    __device__ __forceinline__ void operator()(const f32x4 (&acc)[2][2][4][2], const Unit& u, int wr, int wc, int fr, int fq) const {
        const int row0 = u.pm * BM + wr * 64 + fr, col0 = u.pn * BM + wc * 32 + 8 * fq;
#pragma unroll
        for (int ai = 0; ai < 2; ++ai)
#pragma unroll
            for (int m = 0; m < 4; ++m) {
                const int row = row0 + ai * HALF + m * 16;
                const float rs = row_rs(ssq, row);
                bf16_t* rowp = O + (size_t)row * ldc + col0;
#pragma unroll
                for (int bj = 0; bj < 2; ++bj) {
                    const f32x4 v0 = acc[ai][bj][m][0] * rs, v1 = acc[ai][bj][m][1] * rs;
                    u32x4 w; w.x = cvt_pk_bf16(v0[0], v0[1]); w.y = cvt_pk_bf16(v0[2], v0[3]); w.z = cvt_pk_bf16(v1[0], v1[1]); w.w = cvt_pk_bf16(v1[2], v1[3]);
                    *(u32x4*)(rowp + bj * HALF) = w;
                }
            }
    }
};

struct EpiResid {
    static constexpr bool PERM = false, AFTER_DRAIN = false;
    const float* res; float* out; bf16_t* xb; float* ssq_out; float alpha;
    __device__ __forceinline__ void operator()(const f32x4 (&acc)[2][2][4][2], const Unit& u, int wr, int wc, int fr, int fq) const {
        typedef unsigned u32x2v __attribute__((ext_vector_type(2)));
        const int row0 = u.pm * BM + wr * 64 + fr, col0 = u.pn * BM + wc * 32 + 4 * fq;
#pragma unroll
        for (int ai = 0; ai < 2; ++ai)
#pragma unroll
            for (int m = 0; m < 4; ++m) {
                const int row = row0 + ai * HALF + m * 16;
                const size_t off = (size_t)row * 1024 + col0;
                float s = 0.f;
#pragma unroll
                for (int bj = 0; bj < 2; ++bj)
#pragma unroll
                    for (int n = 0; n < 2; ++n) {
                        const f32x4 r4 = *(const f32x4*)(res + off + bj * HALF + n * 16);
                        const f32x4 v = r4 + acc[ai][bj][m][n] * alpha;
                        *(f32x4*)(out + off + bj * HALF + n * 16) = v;
                        s += (v[0] * v[0] + v[1] * v[1]) + (v[2] * v[2] + v[3] * v[3]);
                        if (xb) { u32x2v w; w.x = cvt_pk_bf16(v[0], v[1]); w.y = cvt_pk_bf16(v[2], v[3]); *(u32x2v*)(xb + off + bj * HALF + n * 16) = w; }
                    }
                s += __shfl_xor(s, 16); s += __shfl_xor(s, 32);
                if (fq == 0) atomicAdd(ssq_out + row, s);
            }
    }
};
template <class Epi, class Sched, bool ALIGN_EPI = false, bool SP2 = false>
__device__ __forceinline__ void gemm_phase(PG8_LAS unsigned char* lds, const Gemm g, const Sched& S, const Epi& E) {
    const int tid = threadIdx.x, wid = __builtin_amdgcn_readfirstlane(tid >> 6), lane = tid & 63, wr = wid >> 2, wc = wid & 3, fr = lane & 15, fq = lane >> 4;
    const int K = g.K, nt = K / BK;
    unsigned voffA[2], voffB[2];
#pragma unroll
    for (int i = 0; i < 2; ++i) { int R, C; stage_rc(tid * 16 + i * 8192, R, C); const int Rb = Epi::PERM ? ((R & ~31) + perm32(R & 31)) : R;
        voffA[i] = (unsigned)(R * K + C) * 2u; voffB[i] = (unsigned)(Rb * K + C) * 2u; }
    const size_t kstep = (size_t)(BK * 2);
    const size_t hstep = (size_t)HALF * K * 2;
    const size_t tstep = 2 * hstep;
    const unsigned ldsw = (unsigned)wid * 1024u;
    const int aoff = lds_byte(wr * 64 + fr, fq * 8), boff = lds_byte(wc * 32 + fr, fq * 8);
#define PG8_SA(b, h) (((b) * 2 + (h)) * HTB)
#define PG8_SB(b, h) ((4 + (b) * 2 + (h)) * HTB)
#define PG8_STAGE(bufoff, gbase, voff) do { _Pragma("unroll") for (int _i = 0; _i < 2; ++_i) \
        __builtin_amdgcn_global_load_lds((const unsigned*)((const char*)(gbase) + (voff)[_i]), (PG8_LAS unsigned*)(lds + (bufoff) + ldsw + _i * 8192), 16, 0, 0); } while (0)
#define PG8_LDA(dst, b, h) do { _Pragma("unroll") for (int m = 0; m < 4; ++m) _Pragma("unroll") for (int k = 0; k < 2; ++k) dst[m][k] = *(const PG8_LAS bf16x8*)(lds + PG8_SA(b, h) + aoff + m * 2048 + k * 1024); } while (0)
#define PG8_LDB(dst, b, h) do { _Pragma("unroll") for (int n = 0; n < 2; ++n) _Pragma("unroll") for (int k = 0; k < 2; ++k) dst[n][k] = *(const PG8_LAS bf16x8*)(lds + PG8_SB(b, h) + boff + n * 2048 + k * 1024); } while (0)
#define PG8_MMA(ai, bj, At, Bt) do { __builtin_amdgcn_s_setprio(1); _Pragma("unroll") for (int m = 0; m < 4; ++m) _Pragma("unroll") for (int n = 0; n < 2; ++n) _Pragma("unroll") for (int k = 0; k < 2; ++k) \
        acc[ai][bj][m][n] = __builtin_amdgcn_mfma_f32_16x16x32_bf16(Bt[n][k], At[m][k], acc[ai][bj][m][n], 0, 0, 0); __builtin_amdgcn_s_setprio(0); } while (0)
#define PG8_WAIT_V(n) asm volatile("s_waitcnt vmcnt(" #n ")" ::: "memory")
#define PG8_WAIT_L(n) asm volatile("s_waitcnt lgkmcnt(" #n ")" ::: "memory")
#define PG8_BAR __builtin_amdgcn_s_barrier()
#define PG8_SCHED __builtin_amdgcn_sched_barrier(0)
    Unit cur, nxt; int ui = 0;
    if (!S.next(0, cur)) return;
    f32x4 acc[2][2][4][2];
#pragma unroll
    for (int a = 0; a < 2; ++a)
#pragma unroll
        for (int b = 0; b < 2; ++b)
#pragma unroll
            for (int m = 0; m < 4; ++m)
#pragma unroll
                for (int n = 0; n < 2; ++n) acc[a][b][m][n] = (f32x4){0.f, 0.f, 0.f, 0.f};
    bf16x8 At[4][2], B0[2][2], B1[2][2];
    const char* cA = (const char*)g.A + (size_t)cur.pm * tstep; const char* cB = (const char*)g.Bt + (size_t)cur.pn * tstep;
    S.a_ready(cur);
    if constexpr (SP2) {
        PG8_STAGE(PG8_SB(0, 0), cB, voffB); PG8_STAGE(PG8_SB(0, 1), cB + hstep, voffB); PG8_STAGE(PG8_SA(0, 0), cA, voffA); PG8_STAGE(PG8_SA(0, 1), cA + hstep, voffA);
        if (wr == 1) PG8_BAR;
        PG8_WAIT_V(2); PG8_BAR;
        PG8_STAGE(PG8_SB(1, 0), cB + kstep, voffB); PG8_STAGE(PG8_SA(1, 0), cA + kstep, voffA); PG8_STAGE(PG8_SB(1, 1), cB + hstep + kstep, voffB);
        PG8_WAIT_V(6); PG8_BAR;
    } else {
        PG8_STAGE(PG8_SB(0, 0), cB, voffB); PG8_STAGE(PG8_SA(0, 0), cA, voffA); PG8_STAGE(PG8_SB(0, 1), cB + hstep, voffB); PG8_STAGE(PG8_SA(0, 1), cA + hstep, voffA);
        if (wr == 1) PG8_BAR;
        PG8_WAIT_V(4); PG8_BAR;
        PG8_STAGE(PG8_SB(1, 0), cB + kstep, voffB); PG8_STAGE(PG8_SA(1, 0), cA + kstep, voffA); PG8_STAGE(PG8_SB(1, 1), cB + hstep + kstep, voffB);
        PG8_WAIT_V(6); PG8_BAR;
    }
    for (;;) {
        const bool has_next = S.next(ui + 1, nxt);
        const char* nA = has_next ? (const char*)g.A + (size_t)nxt.pm * tstep : cA; const char* nB = has_next ? (const char*)g.Bt + (size_t)nxt.pn * tstep : cB;
        for (int t = 0; t < nt; t += 2) {
            const bool last = (t == nt - 2);
            const char* a1 = cA + (size_t)(t + 1) * kstep;
            const char* a2 = last ? nA : cA + (size_t)(t + 2) * kstep; const char* b2 = last ? nB : cB + (size_t)(t + 2) * kstep;
            const char* a3 = a2 + kstep; const char* b3 = b2 + kstep;
            if (last && has_next) S.a_ready(nxt);
            if constexpr (SP2) {
            PG8_LDB(B0, 0, 0); PG8_LDB(B1, 0, 1); PG8_SCHED; PG8_LDA(At, 0, 0); PG8_STAGE(PG8_SA(1, 1), a1 + hstep, voffA);
            PG8_WAIT_V(8); PG8_WAIT_L(0); PG8_BAR; PG8_MMA(0, 0, At, B0); PG8_MMA(0, 1, At, B1); PG8_BAR; PG8_SCHED;
            PG8_LDA(At, 0, 1); PG8_STAGE(PG8_SB(0, 0), b2, voffB); PG8_STAGE(PG8_SB(0, 1), b2 + hstep, voffB); PG8_STAGE(PG8_SA(0, 0), a2, voffA);
            PG8_WAIT_V(8); PG8_WAIT_L(0); PG8_BAR; PG8_MMA(1, 0, At, B0); PG8_MMA(1, 1, At, B1); PG8_BAR; PG8_SCHED;
            PG8_LDB(B0, 1, 0); PG8_LDB(B1, 1, 1); PG8_SCHED; PG8_LDA(At, 1, 0); PG8_STAGE(PG8_SA(0, 1), a2 + hstep, voffA);
            PG8_WAIT_V(8); PG8_WAIT_L(0); PG8_BAR; PG8_MMA(0, 0, At, B0); PG8_MMA(0, 1, At, B1); PG8_BAR; PG8_SCHED;
            PG8_LDA(At, 1, 1); PG8_STAGE(PG8_SB(1, 0), b3, voffB); PG8_STAGE(PG8_SB(1, 1), b3 + hstep, voffB); PG8_STAGE(PG8_SA(1, 0), a3, voffA);
            PG8_WAIT_V(8); PG8_WAIT_L(0); PG8_BAR; PG8_MMA(1, 0, At, B0); PG8_MMA(1, 1, At, B1); PG8_BAR; PG8_SCHED;
            } else {
            PG8_LDB(B0, 0, 0); PG8_SCHED; PG8_LDA(At, 0, 0); PG8_STAGE(PG8_SA(1, 1), a1 + hstep, voffA);
            PG8_WAIT_L(8); PG8_BAR; PG8_WAIT_L(0); PG8_MMA(0, 0, At, B0); PG8_BAR; PG8_SCHED;
            PG8_LDB(B1, 0, 1); PG8_STAGE(PG8_SB(0, 0), b2, voffB);
            PG8_BAR; PG8_WAIT_L(0); PG8_MMA(0, 1, At, B1); PG8_BAR;
            PG8_LDA(At, 0, 1); PG8_STAGE(PG8_SA(0, 0), a2, voffA);
            PG8_BAR; PG8_WAIT_L(0); PG8_MMA(1, 0, At, B0); PG8_BAR; PG8_SCHED;
            PG8_STAGE(PG8_SB(0, 1), b2 + hstep, voffB);
            PG8_WAIT_V(6); PG8_BAR; PG8_MMA(1, 1, At, B1); PG8_BAR;
            PG8_LDB(B0, 1, 0); PG8_SCHED; PG8_LDA(At, 1, 0); PG8_STAGE(PG8_SA(0, 1), a2 + hstep, voffA);
            PG8_WAIT_L(8); PG8_BAR; PG8_WAIT_L(0); PG8_MMA(0, 0, At, B0); PG8_BAR; PG8_SCHED;
            PG8_LDB(B1, 1, 1); PG8_STAGE(PG8_SB(1, 0), b3, voffB);
            PG8_BAR; PG8_WAIT_L(0); PG8_MMA(0, 1, At, B1); PG8_BAR;
            PG8_LDA(At, 1, 1); PG8_STAGE(PG8_SA(1, 0), a3, voffA);
            PG8_BAR; PG8_WAIT_L(0); PG8_MMA(1, 0, At, B0); PG8_BAR; PG8_SCHED;
            PG8_STAGE(PG8_SB(1, 1), b3 + hstep, voffB);
            PG8_WAIT_V(6); PG8_BAR; PG8_MMA(1, 1, At, B1); PG8_BAR;
            }
        }
        if constexpr (ALIGN_EPI) { if (wr == 0) PG8_BAR; }
        if constexpr (!Epi::AFTER_DRAIN) { E(acc, cur, wr, wc, fr, fq); S.done(cur); }
        if (!has_next) break;
#pragma unroll
        for (int a = 0; a < 2; ++a)
#pragma unroll
            for (int b = 0; b < 2; ++b)
#pragma unroll
                for (int m = 0; m < 4; ++m)
#pragma unroll
                    for (int n = 0; n < 2; ++n) acc[a][b][m][n] = (f32x4){0.f, 0.f, 0.f, 0.f};
        cur = nxt; cA = nA; cB = nB; ++ui;
        if constexpr (ALIGN_EPI) { if (wr == 1) PG8_BAR; }
    }
    PG8_WAIT_V(0);
    if constexpr (!ALIGN_EPI) { if (wr == 0) PG8_BAR; }
    PG8_BAR;
    if constexpr (Epi::AFTER_DRAIN) { E.fused(acc, cur, wr, wc, fr, fq, lds, wid, lane); S.done(cur); }
#undef PG8_SA
#undef PG8_SB
#undef PG8_STAGE
#undef PG8_LDA
#undef PG8_LDB
#undef PG8_MMA
#undef PG8_WAIT_V
#undef PG8_WAIT_L
#undef PG8_BAR
#undef PG8_SCHED
}
}

#ifndef PG8_SP2
#define PG8_SP2 true
#endif
#define GAS __attribute__((address_space(1)))
#define LAS __attribute__((address_space(3)))
typedef unsigned short bf16;
typedef unsigned v4u __attribute__((ext_vector_type(4)));
typedef float f32x4 __attribute__((ext_vector_type(4)));
typedef short bf16x8 __attribute__((ext_vector_type(8)));
typedef GAS unsigned gu32;
typedef GAS unsigned long long gu64;
#define RLX_AGENT __ATOMIC_RELAXED, __HIP_MEMORY_SCOPE_AGENT
#define LDS_WAIT() asm volatile("s_waitcnt lgkmcnt(0)" ::: "memory")
#define VM_WAIT() asm volatile("s_waitcnt vmcnt(0)" ::: "memory")
__device__ __forceinline__ unsigned long long rt() { return __builtin_amdgcn_s_memrealtime(); }
__device__ __forceinline__ unsigned f2bf(float f) { unsigned u = __builtin_bit_cast(unsigned, f); return (u + 0x7fffu + ((u >> 16) & 1u)) >> 16; }
__device__ __forceinline__ unsigned pk2(float lo, float hi) { return f2bf(lo) | (f2bf(hi) << 16); }

#define XB_TMO      128
#define XB_XCNT(j)  (256  + 64 * (j))
#define XB_XSUB(j)  (1280 + 64 * (j))
#define XB_XGEN(j)  (2304 + 64 * (j))
#define XB_TOP      3328
#define XB_TOPGEN   3392
#define XCD_BAR_WORDS 3456
#define XB_SPIN_CAP (1u << 18)

__device__ __forceinline__ unsigned xb_ld(unsigned* p)              { return __hip_atomic_load(p, __ATOMIC_RELAXED, __HIP_MEMORY_SCOPE_AGENT); }
__device__ __forceinline__ unsigned xb_add(unsigned* p, unsigned v) { return __hip_atomic_fetch_add(p, v, __ATOMIC_RELAXED, __HIP_MEMORY_SCOPE_AGENT); }
__device__ __forceinline__ unsigned xb_xcc_id() { return (unsigned)__builtin_amdgcn_s_getreg((3 << 11) | 20) & 0xFu; }
#define XB_SPIN(cond, bar) do { unsigned _sp = 0; while (cond) { __builtin_amdgcn_s_sleep(1); \
    if ((++_sp & 255u) == 0u) { if (xb_ld(&(bar)[XB_TMO])) break; if (_sp > XB_SPIN_CAP) { atomicAdd(&(bar)[XB_TMO], 1u); break; } } } } while (0)

struct XcdBarrier {
    unsigned* bar; unsigned x;
    volatile LAS unsigned* st;
};

__device__ __forceinline__ XcdBarrier xcd_barrier_post(unsigned* bar, volatile LAS unsigned* st) {
    XcdBarrier b; b.bar = bar; b.x = xb_xcc_id(); b.st = st;
    if (threadIdx.x == 0) (void)xb_add(&bar[XB_XCNT(b.x)], 1u);
    return b;
}
__device__ __forceinline__ void xcd_barrier_complete(unsigned* bar, unsigned x, unsigned& nloc, unsigned& nx) {
    const unsigned G = gridDim.x * gridDim.y * gridDim.z;
    unsigned sum, cnt, mine, sp = 0u;
    for (;;) {
        sum = 0u; cnt = 0u; mine = 0u;
#pragma unroll
        for (unsigned j = 0; j < 16; ++j) { const unsigned c = xb_ld(&bar[XB_XCNT(j)]); sum += c; cnt += (c > 0u) ? 1u : 0u; mine = (j == x) ? c : mine; }
        if (sum == G) break;
        __builtin_amdgcn_s_sleep(1);
        if ((++sp & 255u) == 0u) { if (xb_ld(&bar[XB_TMO])) break; if (sp > XB_SPIN_CAP) { atomicAdd(&bar[XB_TMO], 1u); break; } }
    }
    nloc = mine > 0u ? mine : 1u; nx = cnt > 0u ? cnt : 1u;
}

__device__ __forceinline__ void xcd_barrier(const XcdBarrier& b) {
    asm volatile("s_waitcnt vmcnt(0)" ::: "memory");
    __syncthreads();
    if (threadIdx.x == 0) {
        unsigned* bar = b.bar;
        __builtin_amdgcn_s_waitcnt(0);
        unsigned nloc = b.st[0], nx = b.st[1];
        if (nloc == 0u) { xcd_barrier_complete(bar, b.x, nloc, nx); b.st[0] = nloc; b.st[1] = nx; }
        const unsigned old = xb_add(&bar[XB_XSUB(b.x)], 1u);
        const unsigned gen = old / nloc;
        if (old + 1u == (gen + 1u) * nloc) {
            __builtin_amdgcn_fence(__ATOMIC_RELEASE, "agent");
            asm volatile("s_waitcnt vmcnt(0)" ::: "memory");
            const unsigned og = xb_add(&bar[XB_TOP], 1u);
            const unsigned tg = og / nx;
            if (og + 1u == (tg + 1u) * nx) xb_add(&bar[XB_TOPGEN], 1u);
            else XB_SPIN(xb_ld(&bar[XB_TOPGEN]) == tg, bar);
            __builtin_amdgcn_fence(__ATOMIC_ACQUIRE, "agent");
            xb_add(&bar[XB_XGEN(b.x)], 1u);
            asm volatile("s_waitcnt vmcnt(0)" ::: "memory");
        } else {
            XB_SPIN(xb_ld(&bar[XB_XGEN(b.x)]) == gen, bar);
            __builtin_amdgcn_fence(__ATOMIC_ACQUIRE, "agent");
            asm volatile("s_waitcnt vmcnt(0)" ::: "memory");
        }
    }
    __syncthreads();
}

constexpr int NWAVES = 8;
constexpr int D_MODEL = 1024, BATCH = 4, SEQ = 8192, D_FF = 2816, TOK = BATCH * SEQ;
constexpr int SSD_HEADS = 16, SSD_INNER = 1024, SSD_STATE = 128, CONV_DIM = 1536;
constexpr int ATT_HEADS = 8, ATT_INNER = 512, MAX_REL = 256, MIX_WIDTH = 1536, PROJ_DIM = 4112;
constexpr int CHUNK = 64, LEFT_CHUNKS = 8;
constexpr int PROJ_N = 4096;
constexpr int PJ_Z = 0, PJ_XBC = 1024, PJ_Q = 2560, PJ_K = 3072, PJ_V = 3584;
constexpr float LOG2E = 1.4426950408889634f;
constexpr float QSCALE = 0.125f * LOG2E;

constexpr size_t MiB = 1u << 20;
constexpr size_t WS_CTL = 0, CTL_ZERO_BYTES = 1 * MiB;
constexpr size_t WS_SSQ = 1 * MiB;
constexpr size_t WS_BIAST = WS_SSQ + 4 * (size_t)TOK * 4;
constexpr size_t WS_WDT = 2 * MiB;
constexpr size_t WS_DTRAW = 3 * MiB;
constexpr size_t WS_WGU1 = 6 * MiB, WS_WD1 = 17 * MiB, WS_WIN = 23 * MiB, WS_WOUT = 31 * MiB, WS_WGU2 = 34 * MiB, WS_WD2 = 45 * MiB;
constexpr size_t WS_XB = 52 * MiB;
constexpr size_t WS_BIG = 116 * MiB;
constexpr size_t WS_YCAT = 372 * MiB;
constexpr size_t WS_END = 468 * MiB;
static_assert(WS_BIAST + 8 * 10 * 1024 * 4 <= WS_WDT && WS_WGU1 + (size_t)2 * D_FF * D_MODEL * 2 <= WS_WD1 && WS_WD1 + (size_t)D_FF * D_MODEL * 2 <= WS_WIN &&
              WS_WIN + (size_t)PROJ_N * D_MODEL * 2 <= WS_WOUT && WS_WOUT + (size_t)MIX_WIDTH * D_MODEL * 2 <= WS_WGU2 && WS_WGU2 + (size_t)2 * D_FF * D_MODEL * 2 <= WS_WD2 &&
              WS_WD2 + (size_t)D_FF * D_MODEL * 2 <= WS_XB && WS_XB + (size_t)TOK * D_MODEL * 2 <= WS_BIG && WS_BIG + (size_t)TOK * PROJ_N * 2 <= WS_YCAT &&
              WS_YCAT + (size_t)TOK * MIX_WIDTH * 2 <= WS_END, "d_ws map");
constexpr int CW_BAR = 4096;

constexpr int RING_OFF = 0, RING_BYTES = 131072;
constexpr int LDSCTL_OFF = RING_BYTES, MISC_OFF = LDSCTL_OFF + 320;
constexpr int LDS_BYTES = 147456;

struct Frame {
    LAS unsigned char* lds;
    volatile LAS unsigned* MISC;
    int tid, lane, wave, vcu, G;
};
__device__ __forceinline__ float wave_sum(float v) {
#pragma unroll
    for (int o = 1; o < 64; o <<= 1) v += __shfl_xor(v, o);
    return v;
}

__device__ __forceinline__ void p0_transpose_item(const float* W, int ldw, int srccol0, int k0, bf16* WT, int K, int dstrow0, const float* ksc, float csc, LAS float* scr, int lane) {
#pragma unroll 8
    for (int i = 0; i < 32; ++i) { const int kk = 2 * i + (lane >> 5); const float sc = ksc ? ksc[k0 + kk] * csc : csc;
        scr[kk * 33 + (lane & 31)] = W[(size_t)(k0 + kk) * ldw + srccol0 + (lane & 31)] * sc; }
    LDS_WAIT(); asm volatile("" ::: "memory");
    const int c = lane & 7;
#pragma unroll
    for (int j = 0; j < 4; ++j) { const int n = (lane >> 3) + 8 * j; const LAS float* s = scr + (8 * c) * 33 + n;
        v4u o; o.x = pk2(s[0 * 33], s[1 * 33]); o.y = pk2(s[2 * 33], s[3 * 33]); o.z = pk2(s[4 * 33], s[5 * 33]); o.w = pk2(s[6 * 33], s[7 * 33]);
        *(GAS v4u*)(WT + (size_t)(dstrow0 + n) * K + k0 + 8 * c) = o; }
    LDS_WAIT(); asm volatile("" ::: "memory");
}

struct Args { const float* in[20]; float* out; unsigned char* ws; int ph_lo, ph_hi; };

__device__ __forceinline__ void p0_prologue(Frame& F, const Args& a) {
    unsigned char* ws = a.ws;
    LAS float* scr = (LAS float*)(F.lds + RING_OFF + F.wave * 16384);
    const int gw = F.vcu * NWAVES + F.wave, NGW = F.G * NWAVES;
    constexpr int I_GU = (2 * D_FF / 32) * (D_MODEL / 64);
    constexpr int I_D = (D_MODEL / 32) * (D_FF / 64);
    constexpr int I_IN = (PROJ_N / 32) * (D_MODEL / 64);
    constexpr int I_OUT = (D_MODEL / 32) * (MIX_WIDTH / 64);
    constexpr int NITEMS = 2 * I_GU + 2 * I_D + I_IN + I_OUT;
    for (int it = gw; it < NITEMS; it += NGW) {
        int r = it;
        if (r < 2 * I_GU) {
            const int f = r / I_GU; r -= f * I_GU;
            const int nb = r / 16, kb = r % 16, pn = nb >> 3, jb = nb & 7;
            const float* src = a.in[f ? (jb < 4 ? 16 : 17) : (jb < 4 ? 2 : 3)];
            p0_transpose_item(src, D_FF, 128 * pn + 32 * (jb & 3), 64 * kb, (bf16*)(ws + (f ? WS_WGU2 : WS_WGU1)), D_MODEL, 32 * nb, a.in[f ? 15 : 1], 1.0f, scr, F.lane);
            continue;
        }
        r -= 2 * I_GU;
        if (r < 2 * I_D) {
            const int f = r / I_D; r -= f * I_D;
            const int nb = r / 44, kb = r % 44;
            p0_transpose_item(a.in[f ? 18 : 4], D_MODEL, 32 * nb, 64 * kb, (bf16*)(ws + (f ? WS_WD2 : WS_WD1)), D_FF, 32 * nb, nullptr, 1.0f, scr, F.lane);
            continue;
        }
        r -= 2 * I_D;
        if (r < I_IN) {
            const int nb = r / 16, kb = r % 16;
            const int sc0 = 32 * nb + (nb >= PJ_Q / 32 ? 16 : 0);
            const float csc = (nb >= PJ_Q / 32 && nb < PJ_K / 32) ? QSCALE : 1.0f;
            p0_transpose_item(a.in[6], PROJ_DIM, sc0, 64 * kb, (bf16*)(ws + WS_WIN), D_MODEL, 32 * nb, a.in[5], csc, scr, F.lane);
            continue;
        }
        r -= I_IN;
        {
            const int nb = r / 24, kb = r % 24;
            p0_transpose_item(a.in[14], D_MODEL, 32 * nb, 64 * kb, (bf16*)(ws + WS_WOUT), MIX_WIDTH, 32 * nb, kb < 16 ? a.in[12] : nullptr, 1.0f, scr, F.lane);
        }
    }
    {
        const int gt = (F.vcu * NWAVES + F.wave) * 64 + F.lane;
        if (gt < 16 * 1024) { const int n = gt >> 10, k = gt & 1023;
            ((bf16*)(ws + WS_WDT))[n * 1024 + k] = (bf16)f2bf(a.in[6][(size_t)k * PROJ_DIM + 2560 + n] * a.in[5][k]); }
    }
    {
        float* BT = (float*)(ws + WS_BIAST);
        for (int e = gw * 64 + F.lane; e < 8 * 10 * 1024; e += NGW * 64) {
            const int h = e / 10240, di = (e / 1024) % 10, r4 = (e >> 8) & 3, ln = (e >> 2) & 63, i = e & 3;
            const int r = r4 * 4 + i, cr = (r & 3) + 8 * (r >> 2) + 4 * (ln >> 5);
            int rel = 32 * (di - 1) + (ln & 31) - cr; rel = rel < -MAX_REL ? -MAX_REL : (rel > MAX_REL ? MAX_REL : rel);
            BT[e] = a.in[13][h * (2 * MAX_REL + 1) + rel + MAX_REL] * LOG2E;
        }
    }
    {
        float* ssq = (float*)(ws + WS_SSQ);
        bf16* XB = (bf16*)(ws + WS_XB);
        for (int m = gw; m < TOK; m += NGW) {
            const GAS f32x4* xr = (const GAS f32x4*)(a.in[0] + (size_t)m * D_MODEL) + F.lane;
            f32x4 v[4]; float s = 0.f;
#pragma unroll
            for (int j = 0; j < 4; ++j) { v[j] = xr[64 * j]; s += (v[j].x * v[j].x + v[j].y * v[j].y) + (v[j].z * v[j].z + v[j].w * v[j].w); }
            s = wave_sum(s);
            GAS unsigned long long* o8 = (GAS unsigned long long*)(XB + (size_t)m * D_MODEL) + F.lane;
#pragma unroll
            for (int j = 0; j < 4; ++j) o8[64 * j] = (unsigned long long)pk2(v[j].x, v[j].y) | ((unsigned long long)pk2(v[j].z, v[j].w) << 32);
            if (F.lane == 0) { ssq[m] = s; ssq[TOK + m] = 0.f; ssq[2 * TOK + m] = 0.f; ssq[3 * TOK + m] = 0.f; }
        }
    }
}

__device__ __forceinline__ void final_norm_phase(Frame& F, float* out, const float* ssq, const float* w) {
    const int gw = F.vcu * NWAVES + F.wave, NGW = F.G * NWAVES;
    f32x4 wv[4];
#pragma unroll
    for (int j = 0; j < 4; ++j) wv[j] = ((const f32x4*)w)[64 * j + F.lane];
    for (int m = gw; m < TOK; m += NGW) {
        GAS f32x4* xr = (GAS f32x4*)(out + (size_t)m * D_MODEL) + F.lane;
        const float rs = __builtin_amdgcn_rsqf(ssq[m] * (1.0f / 1024.0f) + 1e-5f);
#pragma unroll
        for (int j = 0; j < 4; ++j) { f32x4 v = xr[64 * j]; v = v * rs * wv[j]; xr[64 * j] = v; }
    }
}

__device__ __forceinline__ void dt_pass(Frame& F, const bf16* XB, const bf16* WDT, const float* ssq, float* DTRAW) {
    typedef short bf16x8v __attribute__((ext_vector_type(8)));
    for (int r0 = (int)blockIdx.x * 128; r0 < TOK; r0 += F.G * 128) {
        const int rw = r0 + 16 * F.wave, fr = F.lane & 15, fq = F.lane >> 4;
        const bf16* ap = XB + (size_t)(rw + fr) * D_MODEL + 8 * fq;
        const bf16* bp = WDT + (size_t)fr * D_MODEL + 8 * fq;
        f32x4 acc = (f32x4){0.f, 0.f, 0.f, 0.f};
#pragma unroll 8
        for (int kk = 0; kk < 32; ++kk) {
            const bf16x8v av = *(const bf16x8v*)(ap + kk * 32), bv = *(const bf16x8v*)(bp + kk * 32);
            acc = __builtin_amdgcn_mfma_f32_16x16x32_bf16(av, bv, acc, 0, 0, 0);
        }
#pragma unroll
        for (int i = 0; i < 4; ++i) { const int row = rw + 4 * fq + i; DTRAW[(size_t)row * 16 + fr] = acc[i] * pg8::row_rs(ssq, row); }
    }
}

constexpr int N_PHASES = 11;
__global__ void __launch_bounds__(NWAVES * 64, 2) mega_fwd(Args args, int li) {
    extern __shared__ __attribute__((aligned(16))) unsigned char lds[];
    Frame F;
    F.lds = (LAS unsigned char*)lds;
    F.MISC = (volatile LAS unsigned*)(F.lds + MISC_OFF);
    F.tid = threadIdx.x; F.lane = F.tid & 63; F.wave = __builtin_amdgcn_readfirstlane(F.tid >> 6);
    F.G = gridDim.x; { const int bx = blockIdx.x; F.vcu = (F.G % 8 == 0) ? (bx % 8) * (F.G / 8) + bx / 8 : bx; }
    unsigned char* ws = args.ws;
    gu32* ctl = (gu32*)(ws + WS_CTL);
    for (int u = F.tid; u < (LDS_BYTES - LDSCTL_OFF) / 4; u += NWAVES * 64) ((LAS unsigned*)(F.lds + LDSCTL_OFF))[u] = 0u;
    __syncthreads();
    XcdBarrier bar = xcd_barrier_post((unsigned*)(ctl + CW_BAR) + li * XCD_BAR_WORDS, F.MISC + 8);
    const int lo = args.ph_lo, hi = args.ph_hi;
#define IN(k) (lo <= (k) && (k) < hi)
#define SEAM(k) do { if (IN(k) && IN((k) + 1)) xcd_barrier(bar); } while (0)
    float* ssq = (float*)(ws + WS_SSQ);
    bf16* XB = (bf16*)(ws + WS_XB);
    bf16* BIG = (bf16*)(ws + WS_BIG);
    bf16* YCAT = (bf16*)(ws + WS_YCAT);

    if (IN(0)) { p0_prologue(F, args); } SEAM(0);

    if (IN(1)) {
        pg8::Gemm g{XB, (const bf16*)(ws + WS_WGU1), TOK, 2 * D_FF, D_MODEL}; pg8::StaticOrder S; S.init(TOK, 2 * D_FF, F.G, (int)blockIdx.x);
        pg8::EpiSwiglu E{BIG, D_FF, ssq};
        pg8::gemm_phase<pg8::EpiSwiglu, pg8::StaticOrder, true, true>(F.lds + RING_OFF, g, S, E);
    } SEAM(1);

    if (IN(2)) {
        pg8::Gemm g{BIG, (const bf16*)(ws + WS_WD1), TOK, D_MODEL, D_FF}; pg8::StaticOrder S; S.init(TOK, D_MODEL, F.G, (int)blockIdx.x);
        pg8::EpiResid E{args.in[0], args.out, XB, ssq + TOK, 0.5f};
        pg8::gemm_phase<pg8::EpiResid, pg8::StaticOrder, true, true>(F.lds + RING_OFF, g, S, E);
    } SEAM(2);

    if (IN(3)) {
        pg8::Gemm g{XB, (const bf16*)(ws + WS_WIN), TOK, PROJ_N, D_MODEL}; pg8::StaticOrder S; S.init(TOK, PROJ_N, F.G, (int)blockIdx.x);
        pg8::EpiScaleBf16 E{BIG, PROJ_N, ssq + TOK};
        pg8::gemm_phase<pg8::EpiScaleBf16, pg8::StaticOrder, true, true>(F.lds + RING_OFF, g, S, E);
        dt_pass(F, XB, (const bf16*)(ws + WS_WDT), ssq + TOK, (float*)(ws + WS_DTRAW));
    } SEAM(3);

    SEAM(4); SEAM(5); SEAM(6);

    if (IN(7)) {
        pg8::Gemm g{YCAT, (const bf16*)(ws + WS_WOUT), TOK, D_MODEL, MIX_WIDTH}; pg8::StaticOrder S; S.init(TOK, D_MODEL, F.G, (int)blockIdx.x);
        pg8::EpiResid E{args.out, args.out, XB, ssq + 2 * TOK, 1.0f};
        pg8::gemm_phase<pg8::EpiResid, pg8::StaticOrder, true, true>(F.lds + RING_OFF, g, S, E);
    } SEAM(7);

    if (IN(8)) {
        pg8::Gemm g{XB, (const bf16*)(ws + WS_WGU2), TOK, 2 * D_FF, D_MODEL}; pg8::StaticOrder S; S.init(TOK, 2 * D_FF, F.G, (int)blockIdx.x);
        pg8::EpiSwiglu E{BIG, D_FF, ssq + 2 * TOK};
        pg8::gemm_phase<pg8::EpiSwiglu, pg8::StaticOrder, true, true>(F.lds + RING_OFF, g, S, E);
    } SEAM(8);

    if (IN(9)) {
        pg8::Gemm g{BIG, (const bf16*)(ws + WS_WD2), TOK, D_MODEL, D_FF}; pg8::StaticOrder S; S.init(TOK, D_MODEL, F.G, (int)blockIdx.x);
        pg8::EpiResid E{args.out, args.out, nullptr, ssq + 3 * TOK, 0.5f};
        pg8::gemm_phase<pg8::EpiResid, pg8::StaticOrder, true, true>(F.lds + RING_OFF, g, S, E);
    } SEAM(9);

    if (IN(10)) { final_norm_phase(F, args.out, ssq + 3 * TOK, args.in[19]); }
#undef IN
#undef SEAM
}

extern "C" void kernel_launch(void* const* d_in, const int* in_sizes, int n_in, void* d_out, int out_size, void* d_ws, size_t ws_size, hipStream_t stream) {
    static int grid = 0;
    if (grid == 0) {
        int dev = 0, cus = 0, per_cu = 0;
        if (n_in != 20 || out_size != TOK * D_MODEL || ws_size < 512 * MiB) { fprintf(stderr, "kernel_launch: unexpected shapes (n_in %d out %d ws %zu)\n", n_in, out_size, ws_size); grid = -1; return; }
        if (hipGetDevice(&dev) != hipSuccess || hipDeviceGetAttribute(&cus, hipDeviceAttributeMultiprocessorCount, dev) != hipSuccess) { grid = -1; return; }
        if (hipFuncSetAttribute((const void*)mega_fwd, hipFuncAttributeMaxDynamicSharedMemorySize, LDS_BYTES) != hipSuccess) { fprintf(stderr, "kernel_launch: hipFuncSetAttribute failed\n"); grid = -1; return; }
        if (hipOccupancyMaxActiveBlocksPerMultiprocessor(&per_cu, (const void*)mega_fwd, NWAVES * 64, LDS_BYTES) != hipSuccess || per_cu < 1) { fprintf(stderr, "kernel_launch: occupancy query says %d blocks per CU\n", per_cu); }
        (void)hipGetLastError();
        grid = cus;
    }
    if (grid < 0) return;
    (void)hipMemsetAsync((char*)d_ws + WS_CTL, 0, CTL_ZERO_BYTES, stream);
    Args a{};
    for (int i = 0; i < 20; ++i) a.in[i] = (const float*)d_in[i];
    a.out = (float*)d_out; a.ws = (unsigned char*)d_ws;
    a.ph_lo = 0; a.ph_hi = 4;
    hipLaunchKernelGGL(mega_fwd, dim3(grid), dim3(NWAVES * 64), LDS_BYTES, stream, a, 0);
    {
        const float *cw = (const float*)d_in[7], *cb = (const float*)d_in[8], *dt_bias = (const float*)d_in[9], *a_log = (const float*)d_in[10], *d_skip = (const float*)d_in[11], *rel_bias = (const float*)d_in[13];
        const int L = SEQ;
        char* ws = (char*)d_ws;
        float* XC = (float*)(ws + WS_XB);
        float* DT = (float*)(ws + WS_XB + 50 * MiB);
        float* Y = (float*)(ws + WS_END);
        for (int b = 0; b < 4; ++b) {
            const unsigned short* pj = (const unsigned short*)(ws + WS_BIG) + (size_t)b * L * PROJ_N;
            unsigned short* yc = (unsigned short*)(ws + WS_YCAT) + (size_t)b * L * MIX_WIDTH;
            const float* dtr = (const float*)(ws + WS_DTRAW) + (size_t)b * L * 16;
            nv2::conv_dt_kernel<<<L, 256, 0, stream>>>(pj, dtr, cw, cb, dt_bias, XC, DT);
            nv::ssd_recur_kernel<<<16, 256, 0, stream>>>(XC, DT, a_log, d_skip, Y, L);
            nv2::gated_norm_kernel<<<L, 256, 0, stream>>>(Y, pj, yc);
            nv2::attn_kernel<<<dim3(L / 64, 8), 64, 0, stream>>>(pj, rel_bias, yc);
        }
    }
    a.ph_lo = 7; a.ph_hi = 11;
    hipLaunchKernelGGL(mega_fwd, dim3(grid), dim3(NWAVES * 64), LDS_BYTES, stream, a, 1);
}
```

```cpp
#include <hip/hip_runtime.h>
#include <cstdio>
#include <cstdint>
namespace pg8 {
#define PG8_LAS __attribute__((address_space(3)))
typedef unsigned short bf16_t;
typedef short bf16x8 __attribute__((ext_vector_type(8)));
typedef float f32x4 __attribute__((ext_vector_type(4)));
typedef unsigned u32x4 __attribute__((ext_vector_type(4)));
constexpr int BM = 256, BK = 64, HALF = 128, HTB = HALF * BK * 2  , STAGE_BYTES = 8 * HTB, NXCD = 8, WGM = 8;

__host__ __device__ __forceinline__ int lds_byte(int r, int c) { const int st = (r >> 4) * 2 + (c >> 5), rr = r & 15, cc = c & 31, ob = rr * 64 + cc * 2; return st * 1024 + (ob ^ (((ob >> 9) & 1) << 5)); }
__host__ __device__ __forceinline__ void stage_rc(int b, int& R, int& C) { const int st = b / 1024, sb = b % 1024, swz = sb ^ (((sb >> 9) & 1) << 5); R = (st >> 1) * 16 + swz / 64; C = (st & 1) * 32 + (swz % 64) / 2; }
__host__ __device__ __forceinline__ int perm32(int rho) { const int n = rho >> 4, i = rho & 15; return 8 * (i >> 2) + 4 * n + (i & 3); }

struct Unit { int pm, pn; };
struct Gemm { const bf16_t* A; const bf16_t* Bt; int M, N, K; };

struct StaticOrder {
    int nM, nN, nwg, G, c;
    __host__ __device__ void init(int M, int N, int G_, int c_) { nM = M / BM; nN = N / BM; nwg = nM * nN; G = G_; c = c_; }
    __host__ __device__ bool next(int i, Unit& u) const {
        const long L = (long)i * G + c; if (L >= nwg) return false;
        int wgid = (int)L; { const int q = nwg / NXCD, r = nwg % NXCD, xcd = wgid % NXCD, off = wgid / NXCD; wgid = (xcd < r ? xcd * (q + 1) : r * (q + 1) + (xcd - r) * q) + off; }
        const int nig = WGM * nN, gid = wgid / nig, fm = gid * WGM, gsz = (nM - fm) < WGM ? (nM - fm) : WGM;
        u.pm = fm + ((wgid % nig) % gsz); u.pn = (wgid % nig) / gsz; return true;
    }
    __device__ __forceinline__ void a_ready(const Unit&) const {}
    __device__ __forceinline__ void done(const Unit&) const {}
};

__device__ __forceinline__ unsigned cvt_pk_bf16(float lo, float hi) { unsigned r; asm volatile("v_cvt_pk_bf16_f32 %0, %1, %2" : "=v"(r) : "v"(lo), "v"(hi)); return r; }
typedef float f32x2 __attribute__((ext_vector_type(2)));
constexpr float RMS_EPS = 1e-5f;
__device__ __forceinline__ float silu_fast(float g) { return g * __builtin_amdgcn_rcpf(1.0f + __builtin_amdgcn_exp2f(g * -1.4426950408889634f)); }
__device__ __forceinline__ float row_rs(const float* ssq, int row) { return __builtin_amdgcn_rsqf(ssq[row] * (1.0f / 1024.0f) + RMS_EPS); }

struct EpiSwiglu {
    static constexpr bool PERM = true, AFTER_DRAIN = false;
    bf16_t* O; int ldc; const float* ssq;
    __device__ __forceinline__ void operator()(const f32x4 (&acc)[2][2][4][2], const Unit& u, int wr, int wc, int fr, int fq) const {
        const int row0 = u.pm * BM + wr * 64 + fr, col0 = u.pn * HALF + wc * 32 + 8 * fq;
#pragma unroll
        for (int ai = 0; ai < 2; ++ai)
#pragma unroll
            for (int m = 0; m < 4; ++m) {
                const int row = row0 + ai * HALF + m * 16;
                const float rs = row_rs(ssq, row);
                float v[8];
#pragma unroll
                for (int n = 0; n < 2; ++n)
#pragma unroll
                    for (int i = 0; i < 4; ++i) v[n * 4 + i] = silu_fast(acc[ai][0][m][n][i] * rs) * (acc[ai][1][m][n][i] * rs);
                u32x4 w; w.x = cvt_pk_bf16(v[0], v[1]); w.y = cvt_pk_bf16(v[2], v[3]); w.z = cvt_pk_bf16(v[4], v[5]); w.w = cvt_pk_bf16(v[6], v[7]);
                *(u32x4*)(O + (size_t)row * ldc + col0) = w;
            }
    }
};

struct EpiScaleBf16 {
    static constexpr bool PERM = true, AFTER_DRAIN = false;
    bf16_t* O; int ldc; const float* ssq;
    __device__ __forceinline__ void operator()(const f32x4 (&acc)[2][2][4][2], const Unit& u, int wr, int wc, int fr, int fq) const {
        const int row0 = u.pm * BM + wr * 64 + fr, col0 = u.pn * BM + wc * 32 + 8 * fq;
#pragma unroll
        for (int ai = 0; ai < 2; ++ai)
#pragma unroll
            for (int m = 0; m < 4; ++m) {
                const int row = row0 + ai * HALF + m * 16;
                const float rs = row_rs(ssq, row);
                bf16_t* rowp = O + (size_t)row * ldc + col0;
#pragma unroll
                for (int bj = 0; bj < 2; ++bj) {
                    const f32x4 v0 = acc[ai][bj][m][0] * rs, v1 = acc[ai][bj][m][1] * rs;
                    u32x4 w; w.x = cvt_pk_bf16(v0[0], v0[1]); w.y = cvt_pk_bf16(v0[2], v0[3]); w.z = cvt_pk_bf16(v1[0], v1[1]); w.w = cvt_pk_bf16(v1[2], v1[3]);
                    *(u32x4*)(rowp + bj * HALF) = w;
                }
            }
    }
};

struct EpiResid {
    static constexpr bool PERM = false, AFTER_DRAIN = false;
    const float* res; float* out; bf16_t* xb; float* ssq_out; float alpha;
    __device__ __forceinline__ void operator()(const f32x4 (&acc)[2][2][4][2], const Unit& u, int wr, int wc, int fr, int fq) const {
        typedef unsigned u32x2v __attribute__((ext_vector_type(2)));
        const int row0 = u.pm * BM + wr * 64 + fr, col0 = u.pn * BM + wc * 32 + 4 * fq;
#pragma unroll
        for (int ai = 0; ai < 2; ++ai)
#pragma unroll
            for (int m = 0; m < 4; ++m) {
                const int row = row0 + ai * HALF + m * 16;
                const size_t off = (size_t)row * 1024 + col0;
                float s = 0.f;
#pragma unroll
                for (int bj = 0; bj < 2; ++bj)
#pragma unroll
                    for (int n = 0; n < 2; ++n) {
                        const f32x4 r4 = *(const f32x4*)(res + off + bj * HALF + n * 16);
                        const f32x4 v = r4 + acc[ai][bj][m][n] * alpha;
                        *(f32x4*)(out + off + bj * HALF + n * 16) = v;
                        s += (v[0] * v[0] + v[1] * v[1]) + (v[2] * v[2] + v[3] * v[3]);
                        if (xb) { u32x2v w; w.x = cvt_pk_bf16(v[0], v[1]); w.y = cvt_pk_bf16(v[2], v[3]); *(u32x2v*)(xb + off + bj * HALF + n * 16) = w; }
                    }
                s += __shfl_xor(s, 16); s += __shfl_xor(s, 32);
                if (fq == 0) atomicAdd(ssq_out + row, s);
            }
    }
};
template <class Epi, class Sched, bool ALIGN_EPI = false, bool SP2 = false>
__device__ __forceinline__ void gemm_phase(PG8_LAS unsigned char* lds, const Gemm g, const Sched& S, const Epi& E) {
    const int tid = threadIdx.x, wid = __builtin_amdgcn_readfirstlane(tid >> 6), lane = tid & 63, wr = wid >> 2, wc = wid & 3, fr = lane & 15, fq = lane >> 4;
    const int K = g.K, nt = K / BK;
    unsigned voffA[2], voffB[2];
#pragma unroll
    for (int i = 0; i < 2; ++i) { int R, C; stage_rc(tid * 16 + i * 8192, R, C); const int Rb = Epi::PERM ? ((R & ~31) + perm32(R & 31)) : R;
        voffA[i] = (unsigned)(R * K + C) * 2u; voffB[i] = (unsigned)(Rb * K + C) * 2u; }
    const size_t kstep = (size_t)(BK * 2);
    const size_t hstep = (size_t)HALF * K * 2;
    const size_t tstep = 2 * hstep;
    const unsigned ldsw = (unsigned)wid * 1024u;
    const int aoff = lds_byte(wr * 64 + fr, fq * 8), boff = lds_byte(wc * 32 + fr, fq * 8);
#define PG8_SA(b, h) (((b) * 2 + (h)) * HTB)
#define PG8_SB(b, h) ((4 + (b) * 2 + (h)) * HTB)
#define PG8_STAGE(bufoff, gbase, voff) do { _Pragma("unroll") for (int _i = 0; _i < 2; ++_i) \
        __builtin_amdgcn_global_load_lds((const unsigned*)((const char*)(gbase) + (voff)[_i]), (PG8_LAS unsigned*)(lds + (bufoff) + ldsw + _i * 8192), 16, 0, 0); } while (0)
#define PG8_LDA(dst, b, h) do { _Pragma("unroll") for (int m = 0; m < 4; ++m) _Pragma("unroll") for (int k = 0; k < 2; ++k) dst[m][k] = *(const PG8_LAS bf16x8*)(lds + PG8_SA(b, h) + aoff + m * 2048 + k * 1024); } while (0)
#define PG8_LDB(dst, b, h) do { _Pragma("unroll") for (int n = 0; n < 2; ++n) _Pragma("unroll") for (int k = 0; k < 2; ++k) dst[n][k] = *(const PG8_LAS bf16x8*)(lds + PG8_SB(b, h) + boff + n * 2048 + k * 1024); } while (0)
#define PG8_MMA(ai, bj, At, Bt) do { __builtin_amdgcn_s_setprio(1); _Pragma("unroll") for (int m = 0; m < 4; ++m) _Pragma("unroll") for (int n = 0; n < 2; ++n) _Pragma("unroll") for (int k = 0; k < 2; ++k) \
        acc[ai][bj][m][n] = __builtin_amdgcn_mfma_f32_16x16x32_bf16(Bt[n][k], At[m][k], acc[ai][bj][m][n], 0, 0, 0); __builtin_amdgcn_s_setprio(0); } while (0)
#define PG8_WAIT_V(n) asm volatile("s_waitcnt vmcnt(" #n ")" ::: "memory")
#define PG8_WAIT_L(n) asm volatile("s_waitcnt lgkmcnt(" #n ")" ::: "memory")
#define PG8_BAR __builtin_amdgcn_s_barrier()
#define PG8_SCHED __builtin_amdgcn_sched_barrier(0)
    Unit cur, nxt; int ui = 0;
    if (!S.next(0, cur)) return;
    f32x4 acc[2][2][4][2];
#pragma unroll
    for (int a = 0; a < 2; ++a)
#pragma unroll
        for (int b = 0; b < 2; ++b)
#pragma unroll
            for (int m = 0; m < 4; ++m)
#pragma unroll
                for (int n = 0; n < 2; ++n) acc[a][b][m][n] = (f32x4){0.f, 0.f, 0.f, 0.f};
    bf16x8 At[4][2], B0[2][2], B1[2][2];
    const char* cA = (const char*)g.A + (size_t)cur.pm * tstep; const char* cB = (const char*)g.Bt + (size_t)cur.pn * tstep;
    S.a_ready(cur);
    if constexpr (SP2) {
        PG8_STAGE(PG8_SB(0, 0), cB, voffB); PG8_STAGE(PG8_SB(0, 1), cB + hstep, voffB); PG8_STAGE(PG8_SA(0, 0), cA, voffA); PG8_STAGE(PG8_SA(0, 1), cA + hstep, voffA);
        if (wr == 1) PG8_BAR;
        PG8_WAIT_V(2); PG8_BAR;
        PG8_STAGE(PG8_SB(1, 0), cB + kstep, voffB); PG8_STAGE(PG8_SA(1, 0), cA + kstep, voffA); PG8_STAGE(PG8_SB(1, 1), cB + hstep + kstep, voffB);
        PG8_WAIT_V(6); PG8_BAR;
    } else {
        PG8_STAGE(PG8_SB(0, 0), cB, voffB); PG8_STAGE(PG8_SA(0, 0), cA, voffA); PG8_STAGE(PG8_SB(0, 1), cB + hstep, voffB); PG8_STAGE(PG8_SA(0, 1), cA + hstep, voffA);
        if (wr == 1) PG8_BAR;
        PG8_WAIT_V(4); PG8_BAR;
        PG8_STAGE(PG8_SB(1, 0), cB + kstep, voffB); PG8_STAGE(PG8_SA(1, 0), cA + kstep, voffA); PG8_STAGE(PG8_SB(1, 1), cB + hstep + kstep, voffB);
        PG8_WAIT_V(6); PG8_BAR;
    }
    for (;;) {
        const bool has_next = S.next(ui + 1, nxt);
        const char* nA = has_next ? (const char*)g.A + (size_t)nxt.pm * tstep : cA; const char* nB = has_next ? (const char*)g.Bt + (size_t)nxt.pn * tstep : cB;
        for (int t = 0; t < nt; t += 2) {
            const bool last = (t == nt - 2);
            const char* a1 = cA + (size_t)(t + 1) * kstep;
            const char* a2 = last ? nA : cA + (size_t)(t + 2) * kstep; const char* b2 = last ? nB : cB + (size_t)(t + 2) * kstep;
            const char* a3 = a2 + kstep; const char* b3 = b2 + kstep;
            if (last && has_next) S.a_ready(nxt);
            if constexpr (SP2) {
            PG8_LDB(B0, 0, 0); PG8_LDB(B1, 0, 1); PG8_SCHED; PG8_LDA(At, 0, 0); PG8_STAGE(PG8_SA(1, 1), a1 + hstep, voffA);
            PG8_WAIT_V(8); PG8_WAIT_L(0); PG8_BAR; PG8_MMA(0, 0, At, B0); PG8_MMA(0, 1, At, B1); PG8_BAR; PG8_SCHED;
            PG8_LDA(At, 0, 1); PG8_STAGE(PG8_SB(0, 0), b2, voffB); PG8_STAGE(PG8_SB(0, 1), b2 + hstep, voffB); PG8_STAGE(PG8_SA(0, 0), a2, voffA);
            PG8_WAIT_V(8); PG8_WAIT_L(0); PG8_BAR; PG8_MMA(1, 0, At, B0); PG8_MMA(1, 1, At, B1); PG8_BAR; PG8_SCHED;
            PG8_LDB(B0, 1, 0); PG8_LDB(B1, 1, 1); PG8_SCHED; PG8_LDA(At, 1, 0); PG8_STAGE(PG8_SA(0, 1), a2 + hstep, voffA);
            PG8_WAIT_V(8); PG8_WAIT_L(0); PG8_BAR; PG8_MMA(0, 0, At, B0); PG8_MMA(0, 1, At, B1); PG8_BAR; PG8_SCHED;
            PG8_LDA(At, 1, 1); PG8_STAGE(PG8_SB(1, 0), b3, voffB); PG8_STAGE(PG8_SB(1, 1), b3 + hstep, voffB); PG8_STAGE(PG8_SA(1, 0), a3, voffA);
            PG8_WAIT_V(8); PG8_WAIT_L(0); PG8_BAR; PG8_MMA(1, 0, At, B0); PG8_MMA(1, 1, At, B1); PG8_BAR; PG8_SCHED;
            } else {
            PG8_LDB(B0, 0, 0); PG8_SCHED; PG8_LDA(At, 0, 0); PG8_STAGE(PG8_SA(1, 1), a1 + hstep, voffA);
            PG8_WAIT_L(8); PG8_BAR; PG8_WAIT_L(0); PG8_MMA(0, 0, At, B0); PG8_BAR; PG8_SCHED;
            PG8_LDB(B1, 0, 1); PG8_STAGE(PG8_SB(0, 0), b2, voffB);
            PG8_BAR; PG8_WAIT_L(0); PG8_MMA(0, 1, At, B1); PG8_BAR;
            PG8_LDA(At, 0, 1); PG8_STAGE(PG8_SA(0, 0), a2, voffA);
            PG8_BAR; PG8_WAIT_L(0); PG8_MMA(1, 0, At, B0); PG8_BAR; PG8_SCHED;
            PG8_STAGE(PG8_SB(0, 1), b2 + hstep, voffB);
            PG8_WAIT_V(6); PG8_BAR; PG8_MMA(1, 1, At, B1); PG8_BAR;
            PG8_LDB(B0, 1, 0); PG8_SCHED; PG8_LDA(At, 1, 0); PG8_STAGE(PG8_SA(0, 1), a2 + hstep, voffA);
            PG8_WAIT_L(8); PG8_BAR; PG8_WAIT_L(0); PG8_MMA(0, 0, At, B0); PG8_BAR; PG8_SCHED;
            PG8_LDB(B1, 1, 1); PG8_STAGE(PG8_SB(1, 0), b3, voffB);
            PG8_BAR; PG8_WAIT_L(0); PG8_MMA(0, 1, At, B1); PG8_BAR;
            PG8_LDA(At, 1, 1); PG8_STAGE(PG8_SA(1, 0), a3, voffA);
            PG8_BAR; PG8_WAIT_L(0); PG8_MMA(1, 0, At, B0); PG8_BAR; PG8_SCHED;
            PG8_STAGE(PG8_SB(1, 1), b3 + hstep, voffB);
            PG8_WAIT_V(6); PG8_BAR; PG8_MMA(1, 1, At, B1); PG8_BAR;
            }
        }
        if constexpr (ALIGN_EPI) { if (wr == 0) PG8_BAR; }
        if constexpr (!Epi::AFTER_DRAIN) { E(acc, cur, wr, wc, fr, fq); S.done(cur); }
        if (!has_next) break;
#pragma unroll
        for (int a = 0; a < 2; ++a)
#pragma unroll
            for (int b = 0; b < 2; ++b)
#pragma unroll
                for (int m = 0; m < 4; ++m)
#pragma unroll
                    for (int n = 0; n < 2; ++n) acc[a][b][m][n] = (f32x4){0.f, 0.f, 0.f, 0.f};
        cur = nxt; cA = nA; cB = nB; ++ui;
        if constexpr (ALIGN_EPI) { if (wr == 1) PG8_BAR; }
    }
    PG8_WAIT_V(0);
    if constexpr (!ALIGN_EPI) { if (wr == 0) PG8_BAR; }
    PG8_BAR;
    if constexpr (Epi::AFTER_DRAIN) { E.fused(acc, cur, wr, wc, fr, fq, lds, wid, lane); S.done(cur); }
#undef PG8_SA
#undef PG8_SB
#undef PG8_STAGE
#undef PG8_LDA
#undef PG8_LDB
#undef PG8_MMA
#undef PG8_WAIT_V
#undef PG8_WAIT_L
#undef PG8_BAR
#undef PG8_SCHED
}
}

#ifndef PG8_SP2
#define PG8_SP2 true
#endif
#define GAS __attribute__((address_space(1)))
#define LAS __attribute__((address_space(3)))
typedef unsigned short bf16;
typedef unsigned v4u __attribute__((ext_vector_type(4)));
typedef float f32x4 __attribute__((ext_vector_type(4)));
typedef short bf16x8 __attribute__((ext_vector_type(8)));
typedef GAS unsigned gu32;
typedef GAS unsigned long long gu64;
#define RLX_AGENT __ATOMIC_RELAXED, __HIP_MEMORY_SCOPE_AGENT
#define LDS_WAIT() asm volatile("s_waitcnt lgkmcnt(0)" ::: "memory")
#define VM_WAIT() asm volatile("s_waitcnt vmcnt(0)" ::: "memory")
__device__ __forceinline__ unsigned long long rt() { return __builtin_amdgcn_s_memrealtime(); }
__device__ __forceinline__ unsigned f2bf(float f) { unsigned u = __builtin_bit_cast(unsigned, f); return (u + 0x7fffu + ((u >> 16) & 1u)) >> 16; }
__device__ __forceinline__ unsigned pk2(float lo, float hi) { return f2bf(lo) | (f2bf(hi) << 16); }

#define XB_TMO      128
#define XB_XCNT(j)  (256  + 64 * (j))
#define XB_XSUB(j)  (1280 + 64 * (j))
#define XB_XGEN(j)  (2304 + 64 * (j))
#define XB_TOP      3328
#define XB_TOPGEN   3392
#define XCD_BAR_WORDS 3456
#define XB_SPIN_CAP (1u << 18)

__device__ __forceinline__ unsigned xb_ld(unsigned* p)              { return __hip_atomic_load(p, __ATOMIC_RELAXED, __HIP_MEMORY_SCOPE_AGENT); }
__device__ __forceinline__ unsigned xb_add(unsigned* p, unsigned v) { return __hip_atomic_fetch_add(p, v, __ATOMIC_RELAXED, __HIP_MEMORY_SCOPE_AGENT); }
__device__ __forceinline__ unsigned xb_xcc_id() { return (unsigned)__builtin_amdgcn_s_getreg((3 << 11) | 20) & 0xFu; }
#define XB_SPIN(cond, bar) do { unsigned _sp = 0; while (cond) { __builtin_amdgcn_s_sleep(1); \
    if ((++_sp & 255u) == 0u) { if (xb_ld(&(bar)[XB_TMO])) break; if (_sp > XB_SPIN_CAP) { atomicAdd(&(bar)[XB_TMO], 1u); break; } } } } while (0)

struct XcdBarrier {
    unsigned* bar; unsigned x;
    volatile LAS unsigned* st;
};

__device__ __forceinline__ XcdBarrier xcd_barrier_post(unsigned* bar, volatile LAS unsigned* st) {
    XcdBarrier b; b.bar = bar; b.x = xb_xcc_id(); b.st = st;
    if (threadIdx.x == 0) (void)xb_add(&bar[XB_XCNT(b.x)], 1u);
    return b;
}
__device__ __forceinline__ void xcd_barrier_complete(unsigned* bar, unsigned x, unsigned& nloc, unsigned& nx) {
    const unsigned G = gridDim.x * gridDim.y * gridDim.z;
    unsigned sum, cnt, mine, sp = 0u;
    for (;;) {
        sum = 0u; cnt = 0u; mine = 0u;
#pragma unroll
        for (unsigned j = 0; j < 16; ++j) { const unsigned c = xb_ld(&bar[XB_XCNT(j)]); sum += c; cnt += (c > 0u) ? 1u : 0u; mine = (j == x) ? c : mine; }
        if (sum == G) break;
        __builtin_amdgcn_s_sleep(1);
        if ((++sp & 255u) == 0u) { if (xb_ld(&bar[XB_TMO])) break; if (sp > XB_SPIN_CAP) { atomicAdd(&bar[XB_TMO], 1u); break; } }
    }
    nloc = mine > 0u ? mine : 1u; nx = cnt > 0u ? cnt : 1u;
}

__device__ __forceinline__ void xcd_barrier(const XcdBarrier& b) {
    asm volatile("s_waitcnt vmcnt(0)" ::: "memory");
    __syncthreads();
    if (threadIdx.x == 0) {
        unsigned* bar = b.bar;
        __builtin_amdgcn_s_waitcnt(0);
        unsigned nloc = b.st[0], nx = b.st[1];
        if (nloc == 0u) { xcd_barrier_complete(bar, b.x, nloc, nx); b.st[0] = nloc; b.st[1] = nx; }
        const unsigned old = xb_add(&bar[XB_XSUB(b.x)], 1u);
        const unsigned gen = old / nloc;
        if (old + 1u == (gen + 1u) * nloc) {
            __builtin_amdgcn_fence(__ATOMIC_RELEASE, "agent");
            asm volatile("s_waitcnt vmcnt(0)" ::: "memory");
            const unsigned og = xb_add(&bar[XB_TOP], 1u);
            const unsigned tg = og / nx;
            if (og + 1u == (tg + 1u) * nx) xb_add(&bar[XB_TOPGEN], 1u);
            else XB_SPIN(xb_ld(&bar[XB_TOPGEN]) == tg, bar);
            __builtin_amdgcn_fence(__ATOMIC_ACQUIRE, "agent");
            xb_add(&bar[XB_XGEN(b.x)], 1u);
            asm volatile("s_waitcnt vmcnt(0)" ::: "memory");
        } else {
            XB_SPIN(xb_ld(&bar[XB_XGEN(b.x)]) == gen, bar);
            __builtin_amdgcn_fence(__ATOMIC_ACQUIRE, "agent");
            asm volatile("s_waitcnt vmcnt(0)" ::: "memory");
        }
    }
    __syncthreads();
}

constexpr int NWAVES = 8;
constexpr int D_MODEL = 1024, BATCH = 4, SEQ = 8192, D_FF = 2816, TOK = BATCH * SEQ;
constexpr int SSD_HEADS = 16, SSD_INNER = 1024, SSD_STATE = 128, CONV_DIM = 1536;
constexpr int ATT_HEADS = 8, ATT_INNER = 512, MAX_REL = 256, MIX_WIDTH = 1536, PROJ_DIM = 4112;
constexpr int CHUNK = 64, LEFT_CHUNKS = 8;
constexpr int PROJ_N = 4096;
constexpr int PJ_Z = 0, PJ_XBC = 1024, PJ_Q = 2560, PJ_K = 3072, PJ_V = 3584;
constexpr float LOG2E = 1.4426950408889634f;
constexpr float QSCALE = 0.125f * LOG2E;

constexpr size_t MiB = 1u << 20;
constexpr size_t WS_CTL = 0, CTL_ZERO_BYTES = 1 * MiB;
constexpr size_t WS_SSQ = 1 * MiB;
constexpr size_t WS_BIAST = WS_SSQ + 4 * (size_t)TOK * 4;
constexpr size_t WS_WDT = 2 * MiB;
constexpr size_t WS_DTRAW = 3 * MiB;
constexpr size_t WS_WGU1 = 6 * MiB, WS_WD1 = 17 * MiB, WS_WIN = 23 * MiB, WS_WOUT = 31 * MiB, WS_WGU2 = 34 * MiB, WS_WD2 = 45 * MiB;
constexpr size_t WS_XB = 52 * MiB;
constexpr size_t WS_BIG = 116 * MiB;
constexpr size_t WS_YCAT = 372 * MiB;
constexpr size_t WS_CC = 468 * MiB;
constexpr size_t WS_ACS = 484 * MiB;
constexpr size_t WS_DA = 486 * MiB;
constexpr size_t WS_ST = WS_XB;
constexpr size_t WS_END = 487 * MiB;
static_assert(WS_BIAST + 8 * 11 * 1024 * 4 <= WS_WDT && WS_WGU1 + (size_t)2 * D_FF * D_MODEL * 2 <= WS_WD1 && WS_WD1 + (size_t)D_FF * D_MODEL * 2 <= WS_WIN &&
              WS_WIN + (size_t)PROJ_N * D_MODEL * 2 <= WS_WOUT && WS_WOUT + (size_t)MIX_WIDTH * D_MODEL * 2 <= WS_WGU2 && WS_WGU2 + (size_t)2 * D_FF * D_MODEL * 2 <= WS_WD2 &&
              WS_WD2 + (size_t)D_FF * D_MODEL * 2 <= WS_XB && WS_XB + (size_t)TOK * D_MODEL * 2 <= WS_BIG && WS_BIG + (size_t)TOK * PROJ_N * 2 <= WS_YCAT &&
              WS_YCAT + (size_t)TOK * MIX_WIDTH * 2 <= WS_CC && WS_CC + (size_t)TOK * 256 * 2 <= WS_ACS && WS_ACS + (size_t)TOK * 16 * 4 <= WS_DA, "d_ws map");
constexpr int CW_BAR = 4096;

constexpr int RING_OFF = 0, RING_BYTES = 131072;
constexpr int LDSCTL_OFF = RING_BYTES, MISC_OFF = LDSCTL_OFF + 320;
constexpr int LDS_BYTES = 147456;

struct Frame {
    LAS unsigned char* lds;
    volatile LAS unsigned* MISC;
    int tid, lane, wave, vcu, G;
};
__device__ __forceinline__ float wave_sum(float v) {
#pragma unroll
    for (int o = 1; o < 64; o <<= 1) v += __shfl_xor(v, o);
    return v;
}

__device__ __forceinline__ void p0_transpose_item(const float* W, int ldw, int srccol0, int k0, bf16* WT, int K, int dstrow0, const float* ksc, float csc, LAS float* scr, int lane) {
#pragma unroll 8
    for (int i = 0; i < 32; ++i) { const int kk = 2 * i + (lane >> 5); const float sc = ksc ? ksc[k0 + kk] * csc : csc;
        scr[kk * 33 + (lane & 31)] = W[(size_t)(k0 + kk) * ldw + srccol0 + (lane & 31)] * sc; }
    LDS_WAIT(); asm volatile("" ::: "memory");
    const int c = lane & 7;
#pragma unroll
    for (int j = 0; j < 4; ++j) { const int n = (lane >> 3) + 8 * j; const LAS float* s = scr + (8 * c) * 33 + n;
        v4u o; o.x = pk2(s[0 * 33], s[1 * 33]); o.y = pk2(s[2 * 33], s[3 * 33]); o.z = pk2(s[4 * 33], s[5 * 33]); o.w = pk2(s[6 * 33], s[7 * 33]);
        *(GAS v4u*)(WT + (size_t)(dstrow0 + n) * K + k0 + 8 * c) = o; }
    LDS_WAIT(); asm volatile("" ::: "memory");
}

struct Args { const float* in[20]; float* out; unsigned char* ws; int ph_lo, ph_hi; };

__device__ __forceinline__ void p0_prologue(Frame& F, const Args& a) {
    unsigned char* ws = a.ws;
    LAS float* scr = (LAS float*)(F.lds + RING_OFF + F.wave * 16384);
    const int gw = F.vcu * NWAVES + F.wave, NGW = F.G * NWAVES;
    constexpr int I_GU = (2 * D_FF / 32) * (D_MODEL / 64);
    constexpr int I_D = (D_MODEL / 32) * (D_FF / 64);
    constexpr int I_IN = (PROJ_N / 32) * (D_MODEL / 64);
    constexpr int I_OUT = (D_MODEL / 32) * (MIX_WIDTH / 64);
    constexpr int NITEMS = 2 * I_GU + 2 * I_D + I_IN + I_OUT;
    for (int it = gw; it < NITEMS; it += NGW) {
        int r = it;
        if (r < 2 * I_GU) {
            const int f = r / I_GU; r -= f * I_GU;
            const int nb = r / 16, kb = r % 16, pn = nb >> 3, jb = nb & 7;
            const float* src = a.in[f ? (jb < 4 ? 16 : 17) : (jb < 4 ? 2 : 3)];
            p0_transpose_item(src, D_FF, 128 * pn + 32 * (jb & 3), 64 * kb, (bf16*)(ws + (f ? WS_WGU2 : WS_WGU1)), D_MODEL, 32 * nb, a.in[f ? 15 : 1], 1.0f, scr, F.lane);
            continue;
        }
        r -= 2 * I_GU;
        if (r < 2 * I_D) {
            const int f = r / I_D; r -= f * I_D;
            const int nb = r / 44, kb = r % 44;
            p0_transpose_item(a.in[f ? 18 : 4], D_MODEL, 32 * nb, 64 * kb, (bf16*)(ws + (f ? WS_WD2 : WS_WD1)), D_FF, 32 * nb, nullptr, 1.0f, scr, F.lane);
            continue;
        }
        r -= 2 * I_D;
        if (r < I_IN) {
            const int nb = r / 16, kb = r % 16;
            const int sc0 = 32 * nb + (nb >= PJ_Q / 32 ? 16 : 0);
            const float csc = (nb >= PJ_Q / 32 && nb < PJ_K / 32) ? QSCALE : 1.0f;
            p0_transpose_item(a.in[6], PROJ_DIM, sc0, 64 * kb, (bf16*)(ws + WS_WIN), D_MODEL, 32 * nb, a.in[5], csc, scr, F.lane);
            continue;
        }
        r -= I_IN;
        {
            const int nb = r / 24, kb = r % 24;
            p0_transpose_item(a.in[14], D_MODEL, 32 * nb, 64 * kb, (bf16*)(ws + WS_WOUT), MIX_WIDTH, 32 * nb, kb < 16 ? a.in[12] : nullptr, 1.0f, scr, F.lane);
        }
    }
    {
        const int gt = (F.vcu * NWAVES + F.wave) * 64 + F.lane;
        if (gt < 16 * 1024) { const int n = gt >> 10, k = gt & 1023;
            ((bf16*)(ws + WS_WDT))[n * 1024 + k] = (bf16)f2bf(a.in[6][(size_t)k * PROJ_DIM + 2560 + n] * a.in[5][k]); }
    }
    {
        float* BT = (float*)(ws + WS_BIAST);
        for (int e = gw * 64 + F.lane; e < 8 * 11 * 1024; e += NGW * 64) {
            const int h = e / 11264, di = (e / 1024) % 11, r4 = (e >> 8) & 3, ln = (e >> 2) & 63, i = e & 3;
            const int r = r4 * 4 + i, cr = (r & 3) + 8 * (r >> 2) + 4 * (ln >> 5);
            int rel = 32 * (di - 1) + (ln & 31) - cr; rel = rel < -MAX_REL ? -MAX_REL : (rel > MAX_REL ? MAX_REL : rel);
            BT[e] = a.in[13][h * (2 * MAX_REL + 1) + rel + MAX_REL] * LOG2E;
        }
    }
    {
        float* ssq = (float*)(ws + WS_SSQ);
        bf16* XB = (bf16*)(ws + WS_XB);
        for (int m = gw; m < TOK; m += NGW) {
            const GAS f32x4* xr = (const GAS f32x4*)(a.in[0] + (size_t)m * D_MODEL) + F.lane;
            f32x4 v[4]; float s = 0.f;
#pragma unroll
            for (int j = 0; j < 4; ++j) { v[j] = xr[64 * j]; s += (v[j].x * v[j].x + v[j].y * v[j].y) + (v[j].z * v[j].z + v[j].w * v[j].w); }
            s = wave_sum(s);
            GAS unsigned long long* o8 = (GAS unsigned long long*)(XB + (size_t)m * D_MODEL) + F.lane;
#pragma unroll
            for (int j = 0; j < 4; ++j) o8[64 * j] = (unsigned long long)pk2(v[j].x, v[j].y) | ((unsigned long long)pk2(v[j].z, v[j].w) << 32);
            if (F.lane == 0) { ssq[m] = s; ssq[TOK + m] = 0.f; ssq[2 * TOK + m] = 0.f; ssq[3 * TOK + m] = 0.f; }
        }
    }
}

__device__ __forceinline__ void final_norm_phase(Frame& F, float* out, const float* ssq, const float* w) {
    const int gw = F.vcu * NWAVES + F.wave, NGW = F.G * NWAVES;
    f32x4 wv[4];
#pragma unroll
    for (int j = 0; j < 4; ++j) wv[j] = ((const f32x4*)w)[64 * j + F.lane];
    for (int m = gw; m < TOK; m += NGW) {
        GAS f32x4* xr = (GAS f32x4*)(out + (size_t)m * D_MODEL) + F.lane;
        const float rs = __builtin_amdgcn_rsqf(ssq[m] * (1.0f / 1024.0f) + 1e-5f);
#pragma unroll
        for (int j = 0; j < 4; ++j) { f32x4 v = xr[64 * j]; v = v * rs * wv[j]; xr[64 * j] = v; }
    }
}

namespace att {
typedef short bf16x8 __attribute__((ext_vector_type(8)));
typedef short s16x4 __attribute__((ext_vector_type(4)));
typedef float f32x16 __attribute__((ext_vector_type(16)));
typedef float f32x4v __attribute__((ext_vector_type(4)));
typedef unsigned u32x4v __attribute__((ext_vector_type(4)));
typedef unsigned u32x2v __attribute__((ext_vector_type(2)));
constexpr int VROW = 192, VTILE = 64 * VROW;
constexpr int NDI = 11;
__device__ __forceinline__ s16x4 vtr(const LAS unsigned char* p) { typedef short v4i16_t __attribute__((ext_vector_type(4))); return __builtin_bit_cast(s16x4, __builtin_amdgcn_ds_read_tr16_b64_v4i16((LAS v4i16_t*)p)); }
__device__ __forceinline__ unsigned cvtpk(float lo, float hi) { typedef float f2 __attribute__((ext_vector_type(2))); typedef __bf16 b2 __attribute__((ext_vector_type(2))); f2 v = {lo, hi}; b2 b = __builtin_convertvector(v, b2); return __builtin_bit_cast(unsigned, b); }

__device__ __forceinline__ void attn_unit(int b, int c, int h, int qb, const bf16* PROJ, const float* BT, bf16* YCAT, LAS unsigned char* vl, int lane) {
    const int r32 = lane & 31, hi = lane >> 5;
    const size_t rowb = (size_t)b * SEQ;
    const bf16* Qp = PROJ + (rowb + c * 64 + qb * 32 + r32) * PROJ_N + PJ_Q + h * 64 + 8 * hi;
    bf16x8 qr[4];
#pragma unroll
    for (int d0 = 0; d0 < 4; ++d0) qr[d0] = *(const bf16x8*)(Qp + 16 * d0);
    const int t_lo = c >= LEFT_CHUNKS ? 0 : LEFT_CHUNKS - c;
    const bf16* Kp = PROJ + (rowb + (size_t)(c - LEFT_CHUNKS + t_lo) * 64 + r32) * PROJ_N + PJ_K + h * 64 + 8 * hi;
    const bf16* Vp = PROJ + (rowb + (size_t)(c - LEFT_CHUNKS + t_lo) * 64 + (lane >> 3)) * PROJ_N + PJ_V + h * 64 + 8 * (lane & 7);
    const float* BTh = BT + (size_t)h * NDI * 1024 + lane * 4;
    LAS unsigned char* vw = vl + (lane >> 3) * VROW + (lane & 7) * 16;
    const int g = lane >> 4, i4 = lane & 15;
    const LAS unsigned char* vr = vl + (4 * (g >> 1) + (i4 >> 2)) * VROW + (16 * (g & 1) + 4 * (i4 & 3)) * 2;
    f32x16 o[2]; o[0] = f32x16{}; o[1] = f32x16{};
    float m = -INFINITY, l = 0.f;
    bf16x8 kf[2][4]; u32x4v vst[8];
#pragma unroll
    for (int kvb = 0; kvb < 2; ++kvb)
#pragma unroll
        for (int d0 = 0; d0 < 4; ++d0) kf[kvb][d0] = *(const bf16x8*)(Kp + (size_t)kvb * 32 * PROJ_N + 16 * d0);
#pragma unroll
    for (int i = 0; i < 8; ++i) vst[i] = *(const u32x4v*)(Vp + (size_t)i * 8 * PROJ_N);
    for (int t = t_lo; t <= LEFT_CHUNKS; ++t) {
        f32x16 s[2];
#pragma unroll
        for (int kvb = 0; kvb < 2; ++kvb) {
            int di = 17 - 2 * t + qb - kvb; di = di > 10 ? 10 : di;
            const float* bp = BTh + di * 1024;
#pragma unroll
            for (int r4 = 0; r4 < 4; ++r4) { const f32x4v bv = *(const f32x4v*)(bp + r4 * 256); s[kvb][4 * r4 + 0] = bv[0]; s[kvb][4 * r4 + 1] = bv[1]; s[kvb][4 * r4 + 2] = bv[2]; s[kvb][4 * r4 + 3] = bv[3]; }
        }
#pragma unroll
        for (int kvb = 0; kvb < 2; ++kvb)
#pragma unroll
            for (int d0 = 0; d0 < 4; ++d0) s[kvb] = __builtin_amdgcn_mfma_f32_32x32x16_bf16(kf[kvb][d0], qr[d0], s[kvb], 0, 0, 0);
        if (t < LEFT_CHUNKS) {
            Kp += (size_t)64 * PROJ_N;
#pragma unroll
            for (int kvb = 0; kvb < 2; ++kvb)
#pragma unroll
                for (int d0 = 0; d0 < 4; ++d0) kf[kvb][d0] = *(const bf16x8*)(Kp + (size_t)kvb * 32 * PROJ_N + 16 * d0);
        }
        float mx = s[0][0];
#pragma unroll
        for (int r = 1; r < 16; ++r) mx = fmaxf(mx, s[0][r]);
#pragma unroll
        for (int r = 0; r < 16; ++r) mx = fmaxf(mx, s[1][r]);
        mx = fmaxf(mx, __shfl_xor(mx, 32));
        const float mn = fmaxf(m, mx), f = __builtin_amdgcn_exp2f(m - mn);
        m = mn;
        float ps = 0.f;
#pragma unroll
        for (int kvb = 0; kvb < 2; ++kvb)
#pragma unroll
            for (int r = 0; r < 16; ++r) { s[kvb][r] = __builtin_amdgcn_exp2f(s[kvb][r] - mn); ps += s[kvb][r]; }
        l = l * f + ps;
#pragma unroll
        for (int db = 0; db < 2; ++db)
#pragma unroll
            for (int r = 0; r < 16; ++r) o[db][r] *= f;
        bf16x8 pb[2][2];
#pragma unroll
        for (int kvb = 0; kvb < 2; ++kvb)
#pragma unroll
            for (int sx = 0; sx < 2; ++sx) {
                u32x4v w; w.x = cvtpk(s[kvb][8 * sx + 0], s[kvb][8 * sx + 1]); w.y = cvtpk(s[kvb][8 * sx + 2], s[kvb][8 * sx + 3]);
                w.z = cvtpk(s[kvb][8 * sx + 4], s[kvb][8 * sx + 5]); w.w = cvtpk(s[kvb][8 * sx + 6], s[kvb][8 * sx + 7]);
                pb[kvb][sx] = __builtin_bit_cast(bf16x8, w);
            }
#pragma unroll
        for (int i = 0; i < 8; ++i) *(LAS u32x4v*)(vw + i * 8 * VROW) = vst[i];
        if (t < LEFT_CHUNKS) {
            Vp += (size_t)64 * PROJ_N;
#pragma unroll
            for (int i = 0; i < 8; ++i) vst[i] = *(const u32x4v*)(Vp + (size_t)i * 8 * PROJ_N);
        }
#pragma unroll
        for (int db = 0; db < 2; ++db)
#pragma unroll
            for (int kvb = 0; kvb < 2; ++kvb)
#pragma unroll
                for (int sx = 0; sx < 2; ++sx) {
                    const LAS unsigned char* p = vr + (32 * kvb + 16 * sx) * VROW + 64 * db;
                    const s16x4 lo = vtr(p), hh = vtr(p + 8 * VROW);
                    const bf16x8 vf = (bf16x8){lo[0], lo[1], lo[2], lo[3], hh[0], hh[1], hh[2], hh[3]};
                    o[db] = __builtin_amdgcn_mfma_f32_32x32x16_bf16(vf, pb[kvb][sx], o[db], 0, 0, 0);
                }
    }
    l += __shfl_xor(l, 32);
    const float inv = __builtin_amdgcn_rcpf(l);
    bf16* Op = YCAT + (rowb + c * 64 + qb * 32 + r32) * MIX_WIDTH + SSD_INNER + h * 64 + 4 * hi;
#pragma unroll
    for (int db = 0; db < 2; ++db)
#pragma unroll
        for (int a4 = 0; a4 < 4; ++a4) {
            u32x2v w; w.x = cvtpk(o[db][4 * a4 + 0] * inv, o[db][4 * a4 + 1] * inv); w.y = cvtpk(o[db][4 * a4 + 2] * inv, o[db][4 * a4 + 3] * inv);
            *(u32x2v*)(Op + 32 * db + 8 * a4) = w;
        }
}

__device__ __forceinline__ void attn_phase(Frame& F, const bf16* PROJ, const float* BT, bf16* YCAT) {
    const int gw = F.vcu * NWAVES + F.wave, NGW = F.G * NWAVES;
    LAS unsigned char* vl = F.lds + RING_OFF + F.wave * VTILE;
    constexpr int NU = BATCH * ATT_HEADS * (SEQ / CHUNK) * 2;
    for (int u = gw; u < NU; u += NGW) {
        const int qb = u & 1, c = (u >> 1) & 127, bh = u >> 8, h = bh & 7, b = bh >> 3;
        attn_unit(b, c, h, qb, PROJ, BT, YCAT, vl, F.lane);
    }
}
}

namespace ssd {
typedef short bf16x8 __attribute__((ext_vector_type(8)));
typedef short s16x4 __attribute__((ext_vector_type(4)));
typedef float f32x4v __attribute__((ext_vector_type(4)));
typedef unsigned u32x4v __attribute__((ext_vector_type(4)));
typedef unsigned u32x2v __attribute__((ext_vector_type(2)));
constexpr int SQ = 128, NCQ = SEQ / SQ;
constexpr int P136 = 272;
constexpr int P72 = 144;
constexpr int L_BC = 0, L_MH = 0, L_CC = 34816, L_XDT = 34816, L_XDD = 52224, L_BT = 69632, L_XS = 104448, L_ACS = 122880, L_DT = 126976;
static_assert(L_DT + 4096 <= RING_BYTES, "ssd stage-1 LDS map");
constexpr int L3_CC = 0, L3_H0 = 34816, L3_H1 = 53248, L3_ACS = 71680;
__device__ __forceinline__ float bf2f(unsigned short v) { return __uint_as_float((unsigned)v << 16); }
__device__ __forceinline__ float silu_acc(float x) { return x / (1.f + __expf(-x)); }
__device__ __forceinline__ float softplus_f(float x) { return fmaxf(x, 0.f) + log1pf(expf(-fabsf(x))); }
__device__ __forceinline__ unsigned cvtpk(float lo, float hi) { typedef float f2 __attribute__((ext_vector_type(2))); typedef __bf16 b2 __attribute__((ext_vector_type(2))); f2 v = {lo, hi}; b2 b = __builtin_convertvector(v, b2); return __builtin_bit_cast(unsigned, b); }
__device__ __forceinline__ unsigned short f2b(float f) { return (unsigned short)(cvtpk(f, 0.f) & 0xffffu); }
__device__ __forceinline__ s16x4 vtr(const LAS unsigned char* p) { typedef short v4i16_t __attribute__((ext_vector_type(4))); return __builtin_bit_cast(s16x4, __builtin_amdgcn_ds_read_tr16_b64_v4i16((LAS v4i16_t*)p)); }
#define SSD_SYNC() __syncthreads()

struct Ptrs {
    const bf16* PROJ; const float* DTRAW; const float *conv_w, *conv_b, *dt_bias, *a_log, *d_skip;
    bf16* YCAT; bf16* ST; bf16* CCG; float* ACSG; float* DA;
};

template <int NR>
__device__ __forceinline__ void conv8(const bf16* PROJ, size_t trow0, int pos0, int col0, const float* cw, const float* cb, int ch0, float (&out)[NR][8]) {
    float w[4][8], bsv[8];
#pragma unroll
    for (int j = 0; j < 4; ++j) { const f32x4v a = *(const f32x4v*)(cw + j * CONV_DIM + ch0), c = *(const f32x4v*)(cw + j * CONV_DIM + ch0 + 4);
        w[j][0] = a[0]; w[j][1] = a[1]; w[j][2] = a[2]; w[j][3] = a[3]; w[j][4] = c[0]; w[j][5] = c[1]; w[j][6] = c[2]; w[j][7] = c[3]; }
    { const f32x4v a = *(const f32x4v*)(cb + ch0), c = *(const f32x4v*)(cb + ch0 + 4); bsv[0] = a[0]; bsv[1] = a[1]; bsv[2] = a[2]; bsv[3] = a[3]; bsv[4] = c[0]; bsv[5] = c[1]; bsv[6] = c[2]; bsv[7] = c[3]; }
    float raw[NR + 3][8];
#pragma unroll
    for (int i = 0; i < NR + 3; ++i) {
        u32x4v v = (u32x4v){0u, 0u, 0u, 0u};
        if (pos0 - 3 + i >= 0) v = *(const u32x4v*)(PROJ + (trow0 + i - 3) * PROJ_N + col0);
        raw[i][0] = __uint_as_float(v.x << 16); raw[i][1] = __uint_as_float(v.x & 0xffff0000u); raw[i][2] = __uint_as_float(v.y << 16); raw[i][3] = __uint_as_float(v.y & 0xffff0000u);
        raw[i][4] = __uint_as_float(v.z << 16); raw[i][5] = __uint_as_float(v.z & 0xffff0000u); raw[i][6] = __uint_as_float(v.w << 16); raw[i][7] = __uint_as_float(v.w & 0xffff0000u);
    }
#pragma unroll
    for (int r = 0; r < NR; ++r)
#pragma unroll
        for (int c = 0; c < 8; ++c) {
            float s = bsv[c];
#pragma unroll
            for (int j = 0; j < 4; ++j) s = fmaf(w[j][c], raw[r + j][c], s);
            out[r][c] = silu_acc(s);
        }
}

__device__ __forceinline__ void stage1_unit(Frame& F, const Ptrs& P, int b, int cq, int g) {
    LAS unsigned char* lds = F.lds + RING_OFF;
    const int tid = F.tid, lane = F.lane, w = F.wave, fr = lane & 15, fq = lane >> 4;
    const size_t t0 = (size_t)b * SEQ + (size_t)cq * SQ;
    SSD_SYNC();
    {
        const int cg = tid & 31, seg = tid >> 5, l0 = 8 * seg, c8 = 8 * cg, isC = c8 >= 128, n0 = c8 & 127;
        const int ch0 = SSD_INNER + (isC ? 256 : 0) + g * 128 + n0;
        float v[8][8];
        conv8<8>(P.PROJ, t0 + l0, cq * SQ + l0, PJ_XBC + ch0, P.conv_w, P.conv_b, ch0, v);
#pragma unroll
        for (int r = 0; r < 8; ++r) {
            u32x4v o; o.x = cvtpk(v[r][0], v[r][1]); o.y = cvtpk(v[r][2], v[r][3]); o.z = cvtpk(v[r][4], v[r][5]); o.w = cvtpk(v[r][6], v[r][7]);
            *(LAS u32x4v*)(lds + (isC ? L_CC : L_BC) + (l0 + r) * P136 + n0 * 2) = o;
            if (isC) *(u32x4v*)(P.CCG + (t0 + l0 + r) * 256 + g * 128 + n0) = o;
        }
        if (!isC) {
#pragma unroll
            for (int c = 0; c < 8; ++c) {
                u32x4v o; o.x = cvtpk(v[0][c], v[1][c]); o.y = cvtpk(v[2][c], v[3][c]); o.z = cvtpk(v[4][c], v[5][c]); o.w = cvtpk(v[6][c], v[7][c]);
                *(LAS u32x4v*)(lds + L_BT + (n0 + c) * P136 + l0 * 2) = o;
            }
        }
    }
    {
        const int h = g * 8 + w;
        const float a = -expf(P.a_log[h]), dtb = P.dt_bias[h];
        const float d0 = softplus_f(P.DTRAW[(t0 + 2 * lane) * 16 + h] + dtb), d1 = softplus_f(P.DTRAW[(t0 + 2 * lane + 1) * 16 + h] + dtb);
        const float e0 = d0 * a, e1 = d1 * a, s = e0 + e1;
        float incl = s;
#pragma unroll
        for (int o = 1; o < 64; o <<= 1) { const float t = __shfl_up(incl, o); if (lane >= o) incl += t; }
        const float a0 = incl - s + e0, a1 = incl;
        LAS float* ac = (LAS float*)(lds + L_ACS) + w * SQ; LAS float* dl = (LAS float*)(lds + L_DT) + w * SQ;
        ac[2 * lane] = a0; ac[2 * lane + 1] = a1; dl[2 * lane] = d0; dl[2 * lane + 1] = d1;
        P.ACSG[(t0 + 2 * lane) * 16 + h] = a0; P.ACSG[(t0 + 2 * lane + 1) * 16 + h] = a1;
        if (lane == 63) P.DA[((size_t)b * NCQ + cq) * 16 + h] = expf(a1);
    }
    SSD_SYNC();
    f32x4v cbt[8];
#pragma unroll
    for (int st = 0; st < 8; ++st) cbt[st] = (f32x4v){0.f, 0.f, 0.f, 0.f};
    {
        bf16x8 af[4];
#pragma unroll
        for (int kk = 0; kk < 4; ++kk) af[kk] = *(const LAS bf16x8*)(lds + L_CC + (16 * w + fr) * P136 + (kk * 32 + 8 * fq) * 2);
#pragma unroll
        for (int st = 0; st < 8; ++st) if (st <= w) {
#pragma unroll
            for (int kk = 0; kk < 4; ++kk) { const bf16x8 bfv = *(const LAS bf16x8*)(lds + L_BC + (16 * st + fr) * P136 + (kk * 32 + 8 * fq) * 2);
                cbt[st] = __builtin_amdgcn_mfma_f32_16x16x32_bf16(af[kk], bfv, cbt[st], 0, 0, 0); }
        }
    }
    SSD_SYNC();
    for (int hh = 0; hh < 8; ++hh) {
        const int h = g * 8 + hh;
        const LAS float* ac = (const LAS float*)(lds + L_ACS) + hh * SQ; const LAS float* dl = (const LAS float*)(lds + L_DT) + hh * SQ;
        {
            const int cg = tid & 7, seg = tid >> 3, l0 = 2 * seg, p0 = 8 * cg, ch0 = h * 64 + p0;
            float v[2][8];
            conv8<2>(P.PROJ, t0 + l0, cq * SQ + l0, PJ_XBC + ch0, P.conv_w, P.conv_b, ch0, v);
            const float alast = ac[SQ - 1];
            const float dt0 = dl[l0], dt1 = dl[l0 + 1], dd0 = dt0 * __expf(alast - ac[l0]), dd1 = dt1 * __expf(alast - ac[l0 + 1]);
#pragma unroll
            for (int r = 0; r < 2; ++r) { u32x4v o; o.x = cvtpk(v[r][0], v[r][1]); o.y = cvtpk(v[r][2], v[r][3]); o.z = cvtpk(v[r][4], v[r][5]); o.w = cvtpk(v[r][6], v[r][7]);
                *(LAS u32x4v*)(lds + L_XS + (l0 + r) * P72 + p0 * 2) = o; }
#pragma unroll
            for (int c = 0; c < 8; ++c) {
                *(LAS unsigned*)(lds + L_XDT + (p0 + c) * P136 + l0 * 2) = cvtpk(v[0][c] * dt0, v[1][c] * dt1);
                *(LAS unsigned*)(lds + L_XDD + (p0 + c) * P136 + l0 * 2) = cvtpk(v[0][c] * dd0, v[1][c] * dd1);
            }
        }
        {
            float al[4];
#pragma unroll
            for (int i = 0; i < 4; ++i) al[i] = ac[16 * w + 4 * fq + i];
#pragma unroll
            for (int st = 0; st < 8; ++st) if (st <= (w | 1)) {
                const int s = 16 * st + fr; const float as = ac[s];
#pragma unroll
                for (int i = 0; i < 4; ++i) { const int l = 16 * w + 4 * fq + i;
                    const float mv = (st <= w && s <= l) ? cbt[st][i] * __expf(al[i] - as) : 0.f;
                    *(LAS unsigned short*)(lds + L_MH + l * P136 + s * 2) = f2b(mv); }
            }
        }
        SSD_SYNC();
        {
            const float dsk = P.d_skip[h];
            f32x4v acc[4];
#pragma unroll
            for (int pt = 0; pt < 4; ++pt) acc[pt] = (f32x4v){0.f, 0.f, 0.f, 0.f};
#pragma unroll
            for (int kk = 0; kk < 4; ++kk) if (kk <= (w >> 1)) {
                const bf16x8 af = *(const LAS bf16x8*)(lds + L_MH + (16 * w + fr) * P136 + (kk * 32 + 8 * fq) * 2);
#pragma unroll
                for (int pt = 0; pt < 4; ++pt) { const bf16x8 bfv = *(const LAS bf16x8*)(lds + L_XDT + (16 * pt + fr) * P136 + (kk * 32 + 8 * fq) * 2);
                    acc[pt] = __builtin_amdgcn_mfma_f32_16x16x32_bf16(af, bfv, acc[pt], 0, 0, 0); }
            }
#pragma unroll
            for (int pt = 0; pt < 4; ++pt)
#pragma unroll
                for (int i = 0; i < 4; ++i) { const int l = 16 * w + 4 * fq + i, p = 16 * pt + fr;
                    const float xv = bf2f(*(const LAS unsigned short*)(lds + L_XS + l * P72 + p * 2));
                    P.YCAT[(t0 + l) * MIX_WIDTH + h * 64 + p] = f2b(acc[pt][i] + dsk * xv); }
        }
        {
            f32x4v acc[4];
#pragma unroll
            for (int pt = 0; pt < 4; ++pt) acc[pt] = (f32x4v){0.f, 0.f, 0.f, 0.f};
#pragma unroll
            for (int kk = 0; kk < 4; ++kk) {
                const bf16x8 bfv = *(const LAS bf16x8*)(lds + L_BT + (16 * w + fr) * P136 + (kk * 32 + 8 * fq) * 2);
#pragma unroll
                for (int pt = 0; pt < 4; ++pt) { const bf16x8 af = *(const LAS bf16x8*)(lds + L_XDD + (16 * pt + fr) * P136 + (kk * 32 + 8 * fq) * 2);
                    acc[pt] = __builtin_amdgcn_mfma_f32_16x16x32_bf16(af, bfv, acc[pt], 0, 0, 0); }
            }
            bf16* st = P.ST + ((((size_t)b * NCQ + cq) * 16 + h) * SSD_STATE + 16 * w + fr) * 64 + 4 * fq;
#pragma unroll
            for (int pt = 0; pt < 4; ++pt) { u32x2v o; o.x = cvtpk(acc[pt][0], acc[pt][1]); o.y = cvtpk(acc[pt][2], acc[pt][3]); *(u32x2v*)(st + 16 * pt) = o; }
        }
        SSD_SYNC();
    }
}

__device__ __forceinline__ void stage1_phase(Frame& F, const Ptrs& P) {
    constexpr int NU = BATCH * NCQ * 2;
    for (int u = F.vcu; u < NU; u += F.G) { const int g = u & 1, cq = (u >> 1) & (NCQ - 1), b = u >> 7; stage1_unit(F, P, b, cq, g); }
}

__device__ __forceinline__ void scan_phase(Frame& F, bf16* ST, const float* DA) {
    const int NIT = BATCH * 16 * (SSD_STATE * 64 / 4);
    for (int it = F.vcu * (NWAVES * 64) + F.tid; it < NIT; it += F.G * NWAVES * 64) {
        const int e4 = it & 2047, bh = it >> 11, h = bh & 15, b = bh >> 4;
        u32x2v* p = (u32x2v*)(ST + (((size_t)b * NCQ) * 16 + h) * (SSD_STATE * 64) + 4 * e4);
        const float* da = DA + (size_t)b * NCQ * 16 + h;
        constexpr size_t CS = (size_t)16 * SSD_STATE * 64 / 4;
        float s0 = 0.f, s1 = 0.f, s2 = 0.f, s3 = 0.f;
#pragma unroll 8
        for (int cq = 0; cq < NCQ; ++cq) {
            const u32x2v v = p[cq * CS]; const float d = da[cq * 16];
            u32x2v o; o.x = cvtpk(s0, s1); o.y = cvtpk(s2, s3); p[cq * CS] = o;
            s0 = fmaf(s0, d, __uint_as_float(v.x << 16)); s1 = fmaf(s1, d, __uint_as_float(v.x & 0xffff0000u));
            s2 = fmaf(s2, d, __uint_as_float(v.y << 16)); s3 = fmaf(s3, d, __uint_as_float(v.y & 0xffff0000u));
        }
    }
}

__device__ __forceinline__ void stage3_unit(Frame& F, const Ptrs& P, int b, int cq) {
    LAS unsigned char* lds = F.lds + RING_OFF;
    const int tid = F.tid, lane = F.lane, w = F.wave, fr = lane & 15, fq = lane >> 4;
    const size_t t0 = (size_t)b * SEQ + (size_t)cq * SQ;
    SSD_SYNC();
    for (int e = tid; e < 16 * SQ; e += NWAVES * 64) { const int l = e >> 4, h = e & 15; ((LAS float*)(lds + L3_ACS))[h * SQ + l] = P.ACSG[(t0 + l) * 16 + h]; }
    float ssq[4] = {0.f, 0.f, 0.f, 0.f};
    for (int g = 0; g < 2; ++g) {
        SSD_SYNC();
        for (int pc = tid; pc < SQ * 16; pc += NWAVES * 64) { const int l = pc >> 4, c16 = pc & 15;
            *(LAS u32x4v*)(lds + L3_CC + l * P136 + c16 * 16) = *(const u32x4v*)(P.CCG + (t0 + l) * 256 + g * 128 + c16 * 8); }
        {
            const bf16* hp = P.ST + (((size_t)b * NCQ + cq) * 16 + g * 8) * (SSD_STATE * 64);
            for (int pc = tid; pc < SSD_STATE * 8; pc += NWAVES * 64) { const int n = pc >> 3, c8 = pc & 7; *(LAS u32x4v*)(lds + L3_H0 + n * P72 + c8 * 16) = *(const u32x4v*)(hp + n * 64 + c8 * 8); }
        }
        SSD_SYNC();
        bf16x8 af[4];
#pragma unroll
        for (int kk = 0; kk < 4; ++kk) af[kk] = *(const LAS bf16x8*)(lds + L3_CC + (16 * w + fr) * P136 + (kk * 32 + 8 * fq) * 2);
        for (int hh = 0; hh < 8; ++hh) {
            const int h = g * 8 + hh, hb = (hh & 1) ? L3_H1 : L3_H0, hn = (hh & 1) ? L3_H0 : L3_H1;
            if (hh < 7) {
                const bf16* hp = P.ST + (((size_t)b * NCQ + cq) * 16 + h + 1) * (SSD_STATE * 64);
                for (int pc = tid; pc < SSD_STATE * 8; pc += NWAVES * 64) { const int n = pc >> 3, c8 = pc & 7; *(LAS u32x4v*)(lds + hn + n * P72 + c8 * 16) = *(const u32x4v*)(hp + n * 64 + c8 * 8); }
            }
            f32x4v acc[4];
#pragma unroll
            for (int pt = 0; pt < 4; ++pt) acc[pt] = (f32x4v){0.f, 0.f, 0.f, 0.f};
#pragma unroll
            for (int kk = 0; kk < 4; ++kk)
#pragma unroll
                for (int pt = 0; pt < 4; ++pt) {
                    const LAS unsigned char* hp = lds + hb + (kk * 32 + 8 * fq + (fr >> 2)) * P72 + (16 * pt + 4 * (fr & 3)) * 2;
                    const s16x4 lo = vtr(hp), hi4 = vtr(hp + 4 * P72);
                    const bf16x8 bfv = (bf16x8){lo[0], lo[1], lo[2], lo[3], hi4[0], hi4[1], hi4[2], hi4[3]};
                    acc[pt] = __builtin_amdgcn_mfma_f32_16x16x32_bf16(af[kk], bfv, acc[pt], 0, 0, 0);
                }
            const LAS float* ac = (const LAS float*)(lds + L3_ACS) + h * SQ;
#pragma unroll
            for (int i = 0; i < 4; ++i) {
                const int l = 16 * w + 4 * fq + i; const float ea = __expf(ac[l]);
#pragma unroll
                for (int pt = 0; pt < 4; ++pt) {
                    const int p = 16 * pt + fr;
                    bf16* yp = P.YCAT + (t0 + l) * MIX_WIDTH + h * 64 + p;
                    const float y = bf2f(*yp) + ea * acc[pt][i];
                    const float z = bf2f(P.PROJ[(t0 + l) * PROJ_N + PJ_Z + h * 64 + p]);
                    const float yg = y * silu_acc(z);
                    ssq[i] += yg * yg;
                    *yp = f2b(yg);
                }
            }
            SSD_SYNC();
        }
    }
    float rs[4];
#pragma unroll
    for (int i = 0; i < 4; ++i) { float s = ssq[i]; s += __shfl_xor(s, 1); s += __shfl_xor(s, 2); s += __shfl_xor(s, 4); s += __shfl_xor(s, 8); rs[i] = __builtin_amdgcn_rsqf(s * (1.0f / 1024.0f) + 1e-5f); }
    asm volatile("s_waitcnt vmcnt(0)" ::: "memory");
#pragma unroll
    for (int r = 0; r < 16; ++r) {
        const float rsr = __shfl(rs[r & 3], 16 * (r >> 2));
        gu64* rowp = (gu64*)(P.YCAT + (t0 + 16 * w + r) * MIX_WIDTH);
#pragma unroll
        for (int pc = 0; pc < 4; ++pc) {
            const unsigned long long v = __hip_atomic_load(rowp + lane + 64 * pc, RLX_AGENT);
            const unsigned lo = (unsigned)v, hi = (unsigned)(v >> 32);
            const unsigned o0 = cvtpk(__uint_as_float(lo << 16) * rsr, __uint_as_float(lo & 0xffff0000u) * rsr), o1 = cvtpk(__uint_as_float(hi << 16) * rsr, __uint_as_float(hi & 0xffff0000u) * rsr);
            rowp[lane + 64 * pc] = ((unsigned long long)o1 << 32) | o0;
        }
    }
}
__device__ __forceinline__ void stage3_phase(Frame& F, const Ptrs& P) {
    constexpr int NU = BATCH * NCQ;
    for (int u = F.vcu; u < NU; u += F.G) stage3_unit(F, P, u >> 6, u & (NCQ - 1));
}
}

__device__ __forceinline__ void dt_pass(Frame& F, const bf16* XB, const bf16* WDT, const float* ssq, float* DTRAW) {
    typedef short bf16x8v __attribute__((ext_vector_type(8)));
    for (int r0 = (int)blockIdx.x * 128; r0 < TOK; r0 += F.G * 128) {
        const int rw = r0 + 16 * F.wave, fr = F.lane & 15, fq = F.lane >> 4;
        const bf16* ap = XB + (size_t)(rw + fr) * D_MODEL + 8 * fq;
        const bf16* bp = WDT + (size_t)fr * D_MODEL + 8 * fq;
        f32x4 acc = (f32x4){0.f, 0.f, 0.f, 0.f};
#pragma unroll 8
        for (int kk = 0; kk < 32; ++kk) {
            const bf16x8v av = *(const bf16x8v*)(ap + kk * 32), bv = *(const bf16x8v*)(bp + kk * 32);
            acc = __builtin_amdgcn_mfma_f32_16x16x32_bf16(av, bv, acc, 0, 0, 0);
        }
#pragma unroll
        for (int i = 0; i < 4; ++i) { const int row = rw + 4 * fq + i; DTRAW[(size_t)row * 16 + fr] = acc[i] * pg8::row_rs(ssq, row); }
    }
}

constexpr int N_PHASES = 11;
__global__ void __launch_bounds__(NWAVES * 64, 2) mega_fwd(Args args, int li) {
    extern __shared__ __attribute__((aligned(16))) unsigned char lds[];
    Frame F;
    F.lds = (LAS unsigned char*)lds;
    F.MISC = (volatile LAS unsigned*)(F.lds + MISC_OFF);
    F.tid = threadIdx.x; F.lane = F.tid & 63; F.wave = __builtin_amdgcn_readfirstlane(F.tid >> 6);
    F.G = gridDim.x; { const int bx = blockIdx.x; F.vcu = (F.G % 8 == 0) ? (bx % 8) * (F.G / 8) + bx / 8 : bx; }
    unsigned char* ws = args.ws;
    gu32* ctl = (gu32*)(ws + WS_CTL);
    for (int u = F.tid; u < (LDS_BYTES - LDSCTL_OFF) / 4; u += NWAVES * 64) ((LAS unsigned*)(F.lds + LDSCTL_OFF))[u] = 0u;
    __syncthreads();
    XcdBarrier bar = xcd_barrier_post((unsigned*)(ctl + CW_BAR) + li * XCD_BAR_WORDS, F.MISC + 8);
    const int lo = args.ph_lo, hi = args.ph_hi;
#define IN(k) (lo <= (k) && (k) < hi)
#define SEAM(k) do { if (IN(k) && IN((k) + 1)) xcd_barrier(bar); } while (0)
    float* ssq = (float*)(ws + WS_SSQ);
    bf16* XB = (bf16*)(ws + WS_XB);
    bf16* BIG = (bf16*)(ws + WS_BIG);
    bf16* YCAT = (bf16*)(ws + WS_YCAT);

    if (IN(0)) { p0_prologue(F, args); } SEAM(0);

    if (IN(1)) {
        pg8::Gemm g{XB, (const bf16*)(ws + WS_WGU1), TOK, 2 * D_FF, D_MODEL}; pg8::StaticOrder S; S.init(TOK, 2 * D_FF, F.G, (int)blockIdx.x);
        pg8::EpiSwiglu E{BIG, D_FF, ssq};
        pg8::gemm_phase<pg8::EpiSwiglu, pg8::StaticOrder, true, true>(F.lds + RING_OFF, g, S, E);
    } SEAM(1);

    if (IN(2)) {
        pg8::Gemm g{BIG, (const bf16*)(ws + WS_WD1), TOK, D_MODEL, D_FF}; pg8::StaticOrder S; S.init(TOK, D_MODEL, F.G, (int)blockIdx.x);
        pg8::EpiResid E{args.in[0], args.out, XB, ssq + TOK, 0.5f};
        pg8::gemm_phase<pg8::EpiResid, pg8::StaticOrder, true, true>(F.lds + RING_OFF, g, S, E);
    } SEAM(2);

    if (IN(3)) {
        pg8::Gemm g{XB, (const bf16*)(ws + WS_WIN), TOK, PROJ_N, D_MODEL}; pg8::StaticOrder S; S.init(TOK, PROJ_N, F.G, (int)blockIdx.x);
        pg8::EpiScaleBf16 E{BIG, PROJ_N, ssq + TOK};
        pg8::gemm_phase<pg8::EpiScaleBf16, pg8::StaticOrder, true, true>(F.lds + RING_OFF, g, S, E);
        dt_pass(F, XB, (const bf16*)(ws + WS_WDT), ssq + TOK, (float*)(ws + WS_DTRAW));
    } SEAM(3);

    const ssd::Ptrs SP{BIG, (const float*)(ws + WS_DTRAW), args.in[7], args.in[8], args.in[9], args.in[10], args.in[11], YCAT, (bf16*)(ws + WS_ST), (bf16*)(ws + WS_CC), (float*)(ws + WS_ACS), (float*)(ws + WS_DA)};
    if (IN(4)) { ssd::stage1_phase(F, SP); } SEAM(4);
    if (IN(5)) { ssd::scan_phase(F, (bf16*)(ws + WS_ST), (const float*)(ws + WS_DA)); att::attn_phase(F, BIG, (const float*)(ws + WS_BIAST), YCAT); } SEAM(5);
    if (IN(6)) { ssd::stage3_phase(F, SP); } SEAM(6);

    if (IN(7)) {
        pg8::Gemm g{YCAT, (const bf16*)(ws + WS_WOUT), TOK, D_MODEL, MIX_WIDTH}; pg8::StaticOrder S; S.init(TOK, D_MODEL, F.G, (int)blockIdx.x);
        pg8::EpiResid E{args.out, args.out, XB, ssq + 2 * TOK, 1.0f};
        pg8::gemm_phase<pg8::EpiResid, pg8::StaticOrder, true, true>(F.lds + RING_OFF, g, S, E);
    } SEAM(7);

    if (IN(8)) {
        pg8::Gemm g{XB, (const bf16*)(ws + WS_WGU2), TOK, 2 * D_FF, D_MODEL}; pg8::StaticOrder S; S.init(TOK, 2 * D_FF, F.G, (int)blockIdx.x);
        pg8::EpiSwiglu E{BIG, D_FF, ssq + 2 * TOK};
        pg8::gemm_phase<pg8::EpiSwiglu, pg8::StaticOrder, true, true>(F.lds + RING_OFF, g, S, E);
    } SEAM(8);

    if (IN(9)) {
        pg8::Gemm g{BIG, (const bf16*)(ws + WS_WD2), TOK, D_MODEL, D_FF}; pg8::StaticOrder S; S.init(TOK, D_MODEL, F.G, (int)blockIdx.x);
        pg8::EpiResid E{args.out, args.out, nullptr, ssq + 3 * TOK, 0.5f};
        pg8::gemm_phase<pg8::EpiResid, pg8::StaticOrder, true, true>(F.lds + RING_OFF, g, S, E);
    } SEAM(9);

    if (IN(10)) { final_norm_phase(F, args.out, ssq + 3 * TOK, args.in[19]); }
#undef IN
#undef SEAM
}

extern "C" void kernel_launch(void* const* d_in, const int* in_sizes, int n_in, void* d_out, int out_size, void* d_ws, size_t ws_size, hipStream_t stream) {
    static int grid = 0;
    if (grid == 0) {
        int dev = 0, cus = 0, per_cu = 0;
        if (n_in != 20 || out_size != TOK * D_MODEL || ws_size < WS_END) { fprintf(stderr, "kernel_launch: unexpected shapes (n_in %d out %d ws %zu)\n", n_in, out_size, ws_size); grid = -1; return; }
        if (hipGetDevice(&dev) != hipSuccess || hipDeviceGetAttribute(&cus, hipDeviceAttributeMultiprocessorCount, dev) != hipSuccess) { grid = -1; return; }
        if (hipFuncSetAttribute((const void*)mega_fwd, hipFuncAttributeMaxDynamicSharedMemorySize, LDS_BYTES) != hipSuccess) { fprintf(stderr, "kernel_launch: hipFuncSetAttribute failed\n"); grid = -1; return; }
        if (hipOccupancyMaxActiveBlocksPerMultiprocessor(&per_cu, (const void*)mega_fwd, NWAVES * 64, LDS_BYTES) != hipSuccess || per_cu < 1) { fprintf(stderr, "kernel_launch: occupancy query says %d blocks per CU\n", per_cu); grid = -1; return; }
        (void)hipGetLastError();
        grid = cus;
    }
    if (grid < 0) return;
    (void)hipMemsetAsync((char*)d_ws + WS_CTL, 0, CTL_ZERO_BYTES, stream);
    Args a{};
    for (int i = 0; i < 20; ++i) a.in[i] = (const float*)d_in[i];
    a.out = (float*)d_out; a.ws = (unsigned char*)d_ws;
    a.ph_lo = 0; a.ph_hi = N_PHASES;
    hipLaunchKernelGGL(mega_fwd, dim3(grid), dim3(NWAVES * 64), LDS_BYTES, stream, a, 0);
}
```
